# Optimizing an MI355X kernel written in HIP

```python
import jax, jax.numpy as jnp
from jax import lax
import numpy as np

D_MODEL = 2048
BATCH = 4
SEQ = 8192
DEPTH = 1

A_HEADS = 8
A_HEAD_DIM = 128
A_WIDTH = A_HEADS * A_HEAD_DIM
MOBA_BLOCK = 256
MOBA_TOPK = 3
MOBA_Q_CHUNK = 16
B_HEADS = 8
B_KEY_DIM = 128
B_VAL_DIM = 128
B_FWIDTH = B_HEADS * B_KEY_DIM
B_VWIDTH = B_HEADS * B_VAL_DIM
HGRN_CHUNK = 64
FFN_HIDDEN = -(-8 * D_MODEL // (3 * 256)) * 256
IN_SPLIT = (A_WIDTH, A_WIDTH, A_WIDTH, B_FWIDTH, B_FWIDTH, B_VWIDTH, B_VWIDTH, D_MODEL, D_MODEL)
IN_WIDTH = sum(IN_SPLIT)
LN_EPS = 1e-5
RMS_EPS = 1e-6
DEEPNORM_ALPHA = (2.0 * DEPTH) ** 0.25
DEEPNORM_BETA = (8.0 * DEPTH) ** -0.25

kernel_name = 'moba_hgrn2_gated_hybrid_deepnorm'


def layer_norm(x, g, b):
    xf = x.astype(jnp.float32)
    mu = jnp.mean(xf, axis=-1, keepdims=True)
    var = jnp.mean(jnp.square(xf - mu), axis=-1, keepdims=True)
    return ((xf - mu) * lax.rsqrt(var + LN_EPS) * g + b).astype(x.dtype)


def to_heads(t, n_heads):
    Bsz, T, W = t.shape
    return t.reshape(Bsz, T, n_heads, W // n_heads).transpose(0, 2, 1, 3)


def from_heads(t):
    Bsz, H, T, Dh = t.shape
    return t.transpose(0, 2, 1, 3).reshape(Bsz, T, H * Dh)


def moba_attention(q, k, v):
    Bsz, H, T, Dh = q.shape
    T_pad = -(-T // MOBA_BLOCK) * MOBA_BLOCK
    pad = ((0, 0), (0, 0), (0, T_pad - T), (0, 0))
    q = jnp.pad(q, pad)
    k = jnp.pad(k, pad)
    v = jnp.pad(v, pad)
    n_blk = T_pad // MOBA_BLOCK
    n_sel = min(MOBA_TOPK, n_blk)
    scale = Dh ** -0.5
    kb = k.reshape(Bsz, H, n_blk, MOBA_BLOCK, Dh)
    vb = v.reshape(Bsz, H, n_blk, MOBA_BLOCK, Dh)
    k_mean = jnp.mean(kb.astype(jnp.float32), axis=3)
    gate = jnp.einsum('bhtd,bhnd->bhtn', q.astype(jnp.float32), k_mean)
    q_blk = jnp.arange(T_pad) // MOBA_BLOCK
    fully_past = jnp.arange(n_blk)[None, :] < q_blk[:, None]
    gate = jnp.where(fully_past, gate, -jnp.inf)
    _, sel = lax.top_k(gate, n_sel)

    n_q = T_pad // MOBA_Q_CHUNK
    q_c = q.reshape(Bsz, H, n_q, MOBA_Q_CHUNK, Dh).transpose(2, 0, 1, 3, 4)
    sel_c = sel.reshape(Bsz, H, n_q, MOBA_Q_CHUNK, n_sel).transpose(2, 0, 1, 3, 4)
    starts = jnp.arange(n_q, dtype=jnp.int32) * MOBA_Q_CHUNK
    bi = jnp.arange(Bsz)[:, None, None, None]
    hi = jnp.arange(H)[None, :, None, None]

    def chunk_attn(args):
        qc, selc, start = args
        blk = start // MOBA_BLOCK
        blk_start = blk * MOBA_BLOCK
        k_sel = kb[bi, hi, selc]
        v_sel = vb[bi, hi, selc]
        s_sel = jnp.einsum('bhqd,bhqnjd->bhqnj', qc, k_sel).astype(jnp.float32) * scale
        slot_ok = jnp.arange(n_sel) < blk
        s_sel = jnp.where(slot_ok[:, None], s_sel, -jnp.inf)
        k_own = lax.dynamic_slice_in_dim(k, blk_start, MOBA_BLOCK, axis=2)
        v_own = lax.dynamic_slice_in_dim(v, blk_start, MOBA_BLOCK, axis=2)
        s_own = jnp.einsum('bhqd,bhjd->bhqj', qc, k_own).astype(jnp.float32) * scale
        q_pos = start + jnp.arange(MOBA_Q_CHUNK)
        k_pos = blk_start + jnp.arange(MOBA_BLOCK)
        s_own = jnp.where(k_pos[None, :] <= q_pos[:, None], s_own, -jnp.inf)
        scores = jnp.concatenate(
            [s_sel.reshape(Bsz, H, MOBA_Q_CHUNK, n_sel * MOBA_BLOCK), s_own], axis=-1)
        p = jax.nn.softmax(scores, axis=-1).astype(v.dtype)
        p_sel = p[..., :n_sel * MOBA_BLOCK].reshape(Bsz, H, MOBA_Q_CHUNK, n_sel, MOBA_BLOCK)
        p_own = p[..., n_sel * MOBA_BLOCK:]
        return (jnp.einsum('bhqnj,bhqnjd->bhqd', p_sel, v_sel)
                + jnp.einsum('bhqj,bhjd->bhqd', p_own, v_own))

    out = lax.map(chunk_attn, (q_c, sel_c, starts))
    out = out.transpose(1, 2, 0, 3, 4).reshape(Bsz, H, T_pad, Dh)
    return out[:, :, :T]


def hgrn2_recurrence(q, f_logit, i, lower_bound):
    Bsz, H, T, K = q.shape
    V = i.shape[-1]
    C = HGRN_CHUNK
    N = T // C
    lb = lower_bound[None, :, None, :]
    f = lb + (1.0 - lb) * jax.nn.sigmoid(f_logit.astype(jnp.float32))
    log_f = jnp.log(f)
    key = 1.0 - f

    def chunks(t):
        return t.astype(jnp.float32).reshape(Bsz, H, N, C, t.shape[-1]).transpose(2, 0, 1, 3, 4)

    causal = jnp.arange(C)[:, None] >= jnp.arange(C)[None, :]

    def step(S, inp):
        qc, kc, vc, gc = inp
        b = jnp.cumsum(gc, axis=2)
        o_inter = jnp.einsum('bhtk,bhkv->bhtv', qc * jnp.exp(b), S)
        rel = jnp.where(causal[None, None, :, :, None],
                        b[:, :, :, None, :] - b[:, :, None, :, :], -jnp.inf)
        A = jnp.einsum('bhtk,bhsk,bhtsk->bhts', qc, kc, jnp.exp(rel))
        o_intra = jnp.einsum('bhts,bhsv->bhtv', A, vc)
        b_last = b[:, :, -1:, :]
        S_new = (jnp.exp(b_last[:, :, 0, :])[..., None] * S
                 + jnp.einsum('bhsk,bhsv->bhkv', kc * jnp.exp(b_last - b), vc))
        return S_new, o_inter + o_intra

    S0 = jnp.zeros((Bsz, H, K, V), jnp.float32)
    _, outs = lax.scan(step, S0, (chunks(q), chunks(key), chunks(i), chunks(log_f)))
    o = outs.transpose(1, 2, 0, 3, 4).reshape(Bsz, H, T, V)
    return o.astype(i.dtype)


def token_mixer(h, w_in, w_proj_a, w_proj_b, w_out, hgrn_norm_g, lower_bound):
    z = h @ w_in
    parts = []
    off = 0
    for n in IN_SPLIT:
        parts.append(z[..., off:off + n])
        off += n
    qa, ka, va, qb, fb, ib, ogb, ga, gb = parts
    o_a = moba_attention(to_heads(qa, A_HEADS), to_heads(ka, A_HEADS), to_heads(va, A_HEADS))
    o_a = from_heads(o_a)
    o_b = hgrn2_recurrence(to_heads(jax.nn.silu(qb), B_HEADS), to_heads(fb, B_HEADS),
                           to_heads(ib, B_HEADS), lower_bound.reshape(B_HEADS, B_KEY_DIM))
    o_bf = o_b.astype(jnp.float32)
    o_bf = o_bf * lax.rsqrt(jnp.mean(jnp.square(o_bf), axis=-1, keepdims=True) + RMS_EPS)
    o_bf = o_bf * hgrn_norm_g.reshape(B_HEADS, 1, B_VAL_DIM).astype(jnp.float32)
    o_b = from_heads(o_bf.astype(h.dtype)) * jax.nn.sigmoid(ogb)
    y_a = o_a @ w_proj_a
    y_b = o_b @ w_proj_b
    merged = jax.nn.sigmoid(ga) * y_a + jax.nn.sigmoid(gb) * y_b
    return merged @ w_out


def swiglu_ffn(h, w_gate, w_up, w_down):
    return (jax.nn.silu(h @ w_gate) * (h @ w_up)) @ w_down


def setup_inputs(seed: int = 0) -> dict:
    key = jax.random.key(seed)
    ks = jax.random.split(key, 16)

    def nrm(k, shape, scale):
        return jax.random.normal(k, shape, jnp.float32) * scale

    return {
        'x': nrm(ks[0], (BATCH, SEQ, D_MODEL), 1.0),
        'w_in': nrm(ks[1], (DEPTH, D_MODEL, IN_WIDTH), D_MODEL ** -0.5),
        'w_proj_a': nrm(ks[2], (DEPTH, A_WIDTH, D_MODEL), A_WIDTH ** -0.5 * DEEPNORM_BETA),
        'w_proj_b': nrm(ks[3], (DEPTH, B_VWIDTH, D_MODEL), B_VWIDTH ** -0.5 * DEEPNORM_BETA),
        'w_out': nrm(ks[4], (DEPTH, D_MODEL, D_MODEL), D_MODEL ** -0.5 * DEEPNORM_BETA),
        'hgrn_norm_g': 1.0 + nrm(ks[5], (DEPTH, B_VWIDTH), 0.02),
        'hgrn_lb_logits': nrm(ks[6], (DEPTH + 1, B_FWIDTH), 0.5),
        'ln1_g': 1.0 + nrm(ks[7], (DEPTH, D_MODEL), 0.02),
        'ln1_b': nrm(ks[8], (DEPTH, D_MODEL), 0.02),
        'w_gate_ffn': nrm(ks[9], (DEPTH, D_MODEL, FFN_HIDDEN), D_MODEL ** -0.5),
        'w_up_ffn': nrm(ks[10], (DEPTH, D_MODEL, FFN_HIDDEN), D_MODEL ** -0.5),
        'w_down_ffn': nrm(ks[11], (DEPTH, FFN_HIDDEN, D_MODEL), FFN_HIDDEN ** -0.5 * DEEPNORM_BETA),
        'ln2_g': 1.0 + nrm(ks[12], (DEPTH, D_MODEL), 0.02),
        'ln2_b': nrm(ks[13], (DEPTH, D_MODEL), 0.02),
    }


def reference(x, w_in, w_proj_a, w_proj_b, w_out, hgrn_norm_g, hgrn_lb_logits,
              ln1_g, ln1_b, w_gate_ffn, w_up_ffn, w_down_ffn, ln2_g, ln2_b):
    lb_all = jnp.cumsum(jax.nn.softmax(hgrn_lb_logits.astype(jnp.float32), axis=0), axis=0)
    h = x
    for l in range(DEPTH):
        mix = token_mixer(h, w_in[l], w_proj_a[l], w_proj_b[l], w_out[l], hgrn_norm_g[l], lb_all[l])
        h = layer_norm(DEEPNORM_ALPHA * h + mix, ln1_g[l], ln1_b[l])
        ff = swiglu_ffn(h, w_gate_ffn[l], w_up_ffn[l], w_down_ffn[l])
        h = layer_norm(DEEPNORM_ALPHA * h + ff, ln2_g[l], ln2_b[l])
    return h
```

```cpp
#include <hip/hip_runtime.h>
#include <hip/hip_cooperative_groups.h>
#include <cstdio>
#include <cstdint>
namespace cg = cooperative_groups;
namespace pg8 {
#define PG8_LAS __attribute__((address_space(3)))
typedef unsigned short bf16_t;
typedef short bf16x8 __attribute__((ext_vector_type(8)));
typedef float f32x4 __attribute__((ext_vector_type(4)));
typedef unsigned u32x4 __attribute__((ext_vector_type(4)));
constexpr int BM = 256, BK = 64, HALF = 128, HTB = HALF * BK * 2  , STAGE_BYTES = 8 * HTB, NXCD = 8, WGM = 8;

__host__ __device__ __forceinline__ int lds_byte(int r, int c) { const int st = (r >> 4) * 2 + (c >> 5), rr = r & 15, cc = c & 31, ob = rr * 64 + cc * 2; return st * 1024 + (ob ^ (((ob >> 9) & 1) << 5)); }
__host__ __device__ __forceinline__ void stage_rc(int b, int& R, int& C) { const int st = b / 1024, sb = b % 1024, swz = sb ^ (((sb >> 9) & 1) << 5); R = (st >> 1) * 16 + swz / 64; C = (st & 1) * 32 + (swz % 64) / 2; }
__host__ __device__ __forceinline__ int perm32(int rho) { const int n = rho >> 4, i = rho & 15; return 8 * (i >> 2) + 4 * n + (i & 3); }

struct Unit { int pm, pn; };
struct Gemm { const bf16_t* A; const bf16_t* Bt; int M, N, K; };

struct StaticOrder {
    int nM, nN, nwg, G, c;
    __host__ __device__ void init(int M, int N, int G_, int c_) { nM = M / BM; nN = N / BM; nwg = nM * nN; G = G_; c = c_; }
    __host__ __device__ bool next(int i, Unit& u) const {
        const long L = (long)i * G + c; if (L >= nwg) return false;
        int wgid = (int)L; { const int q = nwg / NXCD, r = nwg % NXCD, xcd = wgid % NXCD, off = wgid / NXCD; wgid = (xcd < r ? xcd * (q + 1) : r * (q + 1) + (xcd - r) * q) + off; }
        const int nig = WGM * nN, gid = wgid / nig, fm = gid * WGM, gsz = (nM - fm) < WGM ? (nM - fm) : WGM;
        u.pm = fm + ((wgid % nig) % gsz); u.pn = (wgid % nig) / gsz; return true;
    }
    __device__ __forceinline__ void a_ready(const Unit&) const {}
    __device__ __forceinline__ void done(const Unit&) const {}
};

typedef float f32x2c __attribute__((ext_vector_type(2))); typedef __bf16 bf16x2c __attribute__((ext_vector_type(2)));
__device__ __forceinline__ unsigned cvt_pk_bf16(float lo, float hi) { f32x2c v = {lo, hi}; bf16x2c b = __builtin_convertvector(v, bf16x2c); return __builtin_bit_cast(unsigned, b); }
typedef float f32x2 __attribute__((ext_vector_type(2)));
__device__ __forceinline__ f32x2 gelu_pk(f32x2 v) {
    const f32x2 av = __builtin_elementwise_abs(v), d = av * 0.2316418882f + 1.0f;
    f32x2 t; t.x = __builtin_amdgcn_rcpf(d.x); t.y = __builtin_amdgcn_rcpf(d.y);
    f32x2 q = t * 0.5307027145f + (-0.7265760135f); q = q * t + 0.7107068705f; q = q * t + (-0.142248368f); q = q * t + 0.127414796f; q = q * t;
    const f32x2 s = (v * v) * (-0.72134752044f);
    f32x2 e; e.x = __builtin_amdgcn_exp2f(s.x); e.y = __builtin_amdgcn_exp2f(s.y);
    const f32x2 m = v * (q * e), r = v - m;
    f32x2 o; o.x = v.x < 0.f ? m.x : r.x; o.y = v.y < 0.f ? m.y : r.y; return o;
}

template <int ACT  > struct EpiBf16 {
    static constexpr bool PERM = true, AFTER_DRAIN = false, HAS_MID = false; static_assert(ACT == 0 || ACT == 1, "EpiBf16: ACT is 0 (none) or 1 (gelu_pk)");
    bf16_t* O; int ldc; const float* bias; int split_cols; size_t split_stride; float scale0;
    __device__ __forceinline__ void operator()(const f32x4 (&acc)[2][2][4][2], const Unit& u, int wr, int wc, int fr, int fq) const {
        const int row0 = u.pm * BM + wr * 64 + fr; int colt = u.pn * BM; bf16_t* base = O;
        float sc = 1.f; if (split_cols) { const int t = colt / split_cols; base += (size_t)t * split_stride; colt -= t * split_cols; if (t == 0) sc = scale0; }
        const int col0 = colt + wc * 32 + 8 * fq, bcol0 = u.pn * BM + wc * 32 + 8 * fq;
        f32x4 bv[2][2];
#pragma unroll
        for (int bj = 0; bj < 2; ++bj)
#pragma unroll
            for (int n = 0; n < 2; ++n) bv[bj][n] = bias ? *(const f32x4*)(bias + bcol0 + bj * HALF + 4 * n) : (f32x4){0.f, 0.f, 0.f, 0.f};
#pragma unroll
        for (int ai = 0; ai < 2; ++ai)
#pragma unroll
            for (int m = 0; m < 4; ++m) { bf16_t* rowp = base + (size_t)(row0 + ai * HALF + m * 16) * ldc + col0;
#pragma unroll
                for (int bj = 0; bj < 2; ++bj) { f32x4 v0 = acc[ai][bj][m][0] + bv[bj][0], v1 = acc[ai][bj][m][1] + bv[bj][1];
                    if (ACT == 1) { f32x2 a = gelu_pk((f32x2){v0[0], v0[1]}), b = gelu_pk((f32x2){v0[2], v0[3]}), c = gelu_pk((f32x2){v1[0], v1[1]}), d = gelu_pk((f32x2){v1[2], v1[3]});
                        v0 = (f32x4){a.x, a.y, b.x, b.y}; v1 = (f32x4){c.x, c.y, d.x, d.y}; }
                    v0 = v0 * sc; v1 = v1 * sc; u32x4 w; w.x = cvt_pk_bf16(v0[0], v0[1]); w.y = cvt_pk_bf16(v0[2], v0[3]); w.z = cvt_pk_bf16(v1[0], v1[1]); w.w = cvt_pk_bf16(v1[2], v1[3]);
                    *(u32x4*)(rowp + bj * HALF) = w; } }
    }
};
__device__ __forceinline__ float bf_lo(unsigned w) { return __uint_as_float(w << 16); }
__device__ __forceinline__ float bf_hi(unsigned w) { return __uint_as_float(w & 0xffff0000u); }
__device__ __forceinline__ float sigm(float x) { return __builtin_amdgcn_rcpf(1.f + __builtin_amdgcn_exp2f(-1.4426950408889634f * x)); }
__device__ __forceinline__ float enx(float x) { return __builtin_amdgcn_exp2f(-1.4426950408889634f * x); }

struct EpiSwiGLU {
    static constexpr bool PERM = true, AFTER_DRAIN = false, HAS_MID = false;
    bf16_t* O; int ldc;
    __device__ __forceinline__ void operator()(const f32x4 (&acc)[2][2][4][2], const Unit& u, int wr, int wc, int fr, int fq) const {
        const int row0 = u.pm * BM + wr * 64 + fr, col0 = u.pn * HALF + wc * 32 + 8 * fq;
#pragma unroll
        for (int ai = 0; ai < 2; ++ai)
#pragma unroll
            for (int m = 0; m < 4; ++m) {
                bf16_t* p = O + (size_t)(row0 + ai * HALF + m * 16) * ldc + col0;
                const f32x4 g0 = acc[ai][0][m][0], g1 = acc[ai][0][m][1], u0 = acc[ai][1][m][0], u1 = acc[ai][1][m][1];
                u32x4 w;
                w.x = cvt_pk_bf16(g0[0] * sigm(g0[0]) * u0[0], g0[1] * sigm(g0[1]) * u0[1]);
                w.y = cvt_pk_bf16(g0[2] * sigm(g0[2]) * u0[2], g0[3] * sigm(g0[3]) * u0[3]);
                w.z = cvt_pk_bf16(g1[0] * sigm(g1[0]) * u1[0], g1[1] * sigm(g1[1]) * u1[1]);
                w.w = cvt_pk_bf16(g1[2] * sigm(g1[2]) * u1[2], g1[3] * sigm(g1[3]) * u1[3]);
                *(u32x4*)p = w;
            }
    }
};
struct EpiProj {
    static constexpr bool PERM = true, AFTER_DRAIN = false, HAS_MID = true;
    const bf16_t* Z; int ldz, ga_off, gb_off; bf16_t* O; int ldc;
    __device__ __forceinline__ void mid(f32x4 (&acc)[2][2][4][2], const Unit& u, int wr, int wc, int fr, int fq) const {
        int row0 = u.pm * BM + wr * 64 + fr, col0 = u.pn * BM + wc * 32 + 8 * fq;
        asm volatile("" : "+v"(row0), "+v"(col0));
#pragma unroll
        for (int ai = 0; ai < 2; ++ai)
#pragma unroll
            for (int mp = 0; mp < 2; ++mp) {
                u32x4 ga[2][2], gb[2][2];
#pragma unroll
                for (int mm = 0; mm < 2; ++mm) { const bf16_t* zr = Z + (size_t)(row0 + ai * HALF + (2 * mp + mm) * 16) * ldz + col0;
#pragma unroll
                    for (int bj = 0; bj < 2; ++bj) { ga[mm][bj] = *(const u32x4*)(zr + ga_off + bj * HALF); gb[mm][bj] = *(const u32x4*)(zr + gb_off + bj * HALF); } }
#pragma unroll
                for (int mm = 0; mm < 2; ++mm)
#pragma unroll
                    for (int bj = 0; bj < 2; ++bj) { const int m = 2 * mp + mm; const u32x4 a = ga[mm][bj], b = gb[mm][bj];
#define PJ_R(aw, bw, LO) ((1.f + enx(LO ? bf_lo(bw) : bf_hi(bw))) * __builtin_amdgcn_rcpf(1.f + enx(LO ? bf_lo(aw) : bf_hi(aw))))
                        f32x4 r0, r1;
                        r0[0] = PJ_R(a.x, b.x, 1); r0[1] = PJ_R(a.x, b.x, 0); r0[2] = PJ_R(a.y, b.y, 1); r0[3] = PJ_R(a.y, b.y, 0);
                        r1[0] = PJ_R(a.z, b.z, 1); r1[1] = PJ_R(a.z, b.z, 0); r1[2] = PJ_R(a.w, b.w, 1); r1[3] = PJ_R(a.w, b.w, 0);
#undef PJ_R
                        acc[ai][bj][m][0] *= r0; acc[ai][bj][m][1] *= r1; }
                asm volatile("" : "+v"(acc[ai][0][2 * mp][0]), "+v"(acc[ai][1][2 * mp + 1][1]) :: "memory");
            }
    }
    __device__ __forceinline__ void operator()(const f32x4 (&acc)[2][2][4][2], const Unit& u, int wr, int wc, int fr, int fq) const {
        const int row0 = u.pm * BM + wr * 64 + fr, col0 = u.pn * BM + wc * 32 + 8 * fq;
#pragma unroll
        for (int ai = 0; ai < 2; ++ai)
#pragma unroll
            for (int m = 0; m < 4; ++m) {
                const size_t r = (size_t)(row0 + ai * HALF + m * 16);
                const bf16_t* zr = Z + r * ldz + col0 + gb_off; bf16_t* op = O + r * ldc + col0;
#pragma unroll
                for (int bj = 0; bj < 2; ++bj) {
                    const u32x4 b = *(const u32x4*)(zr + bj * HALF);
                    const f32x4 v0 = acc[ai][bj][m][0], v1 = acc[ai][bj][m][1];
                    u32x4 w;
                    w.x = cvt_pk_bf16(v0[0] * sigm(bf_lo(b.x)), v0[1] * sigm(bf_hi(b.x)));
                    w.y = cvt_pk_bf16(v0[2] * sigm(bf_lo(b.y)), v0[3] * sigm(bf_hi(b.y)));
                    w.z = cvt_pk_bf16(v1[0] * sigm(bf_lo(b.z)), v1[1] * sigm(bf_hi(b.z)));
                    w.w = cvt_pk_bf16(v1[2] * sigm(bf_lo(b.w)), v1[3] * sigm(bf_hi(b.w)));
                    *(u32x4*)(op + bj * HALF) = w;
                }
            }
    }
};
struct EpiPre1 {
    static constexpr bool PERM = false, AFTER_DRAIN = false, HAS_MID = false;
    const float* X; float* P; int ldc; float alpha;
    __device__ __forceinline__ void operator()(const f32x4 (&acc)[2][2][4][2], const Unit& u, int wr, int wc, int fr, int fq) const {
        const int row0 = u.pm * BM + wr * 64 + fr, col0 = u.pn * BM + wc * 32 + 4 * fq;
#pragma unroll
        for (int ai = 0; ai < 2; ++ai)
#pragma unroll
            for (int m = 0; m < 4; ++m) {
                const size_t off = (size_t)(row0 + ai * HALF + m * 16) * ldc + col0;
#pragma unroll
                for (int bj = 0; bj < 2; ++bj)
#pragma unroll
                    for (int n = 0; n < 2; ++n) { const f32x4 xv = *(const f32x4*)(X + off + bj * HALF + n * 16); *(f32x4*)(P + off + bj * HALF + n * 16) = xv * alpha + acc[ai][bj][m][n]; }
            }
    }
};
struct EpiPre2 {
    static constexpr bool PERM = true, AFTER_DRAIN = false, HAS_MID = false;
    const bf16_t* H; bf16_t* O; int ldc; float alpha;
    __device__ __forceinline__ void operator()(const f32x4 (&acc)[2][2][4][2], const Unit& u, int wr, int wc, int fr, int fq) const {
        const int row0 = u.pm * BM + wr * 64 + fr, col0 = u.pn * BM + wc * 32 + 8 * fq;
#pragma unroll
        for (int ai = 0; ai < 2; ++ai)
#pragma unroll
            for (int m = 0; m < 4; ++m) {
                const size_t off = (size_t)(row0 + ai * HALF + m * 16) * ldc + col0;
#pragma unroll
                for (int bj = 0; bj < 2; ++bj) { const u32x4 hv = *(const u32x4*)(H + off + bj * HALF);
                    f32x4 h0, h1; h0[0] = bf_lo(hv.x); h0[1] = bf_hi(hv.x); h0[2] = bf_lo(hv.y); h0[3] = bf_hi(hv.y); h1[0] = bf_lo(hv.z); h1[1] = bf_hi(hv.z); h1[2] = bf_lo(hv.w); h1[3] = bf_hi(hv.w);
                    const f32x4 r0 = h0 * alpha + acc[ai][bj][m][0], r1 = h1 * alpha + acc[ai][bj][m][1];
                    u32x4 w; w.x = cvt_pk_bf16(r0[0], r0[1]); w.y = cvt_pk_bf16(r0[2], r0[3]); w.z = cvt_pk_bf16(r1[0], r1[1]); w.w = cvt_pk_bf16(r1[2], r1[3]);
                    *(u32x4*)(O + off + bj * HALF) = w; }
            }
    }
};

template <class Epi, class Sched, bool ALIGN_EPI = false, bool SP2 = false>
__device__ __forceinline__ void gemm_phase(PG8_LAS unsigned char* lds, const Gemm g, const Sched& S, const Epi& E) {
    const int tid = threadIdx.x, wid = __builtin_amdgcn_readfirstlane(tid >> 6), lane = tid & 63, wr = wid >> 2, wc = wid & 3, fr = lane & 15, fq = lane >> 4;
    const int K = g.K, nt = K / BK;
    unsigned voffA[2], voffB[2];
#pragma unroll
    for (int i = 0; i < 2; ++i) { int R, C; stage_rc(tid * 16 + i * 8192, R, C); const int Rb = Epi::PERM ? ((R & ~31) + perm32(R & 31)) : R;
        voffA[i] = (unsigned)(R * K + C) * 2u; voffB[i] = (unsigned)(Rb * K + C) * 2u; }
    const size_t kstep = (size_t)(BK * 2);
    const size_t hstep = (size_t)HALF * K * 2;
    const size_t tstep = 2 * hstep;
    const unsigned ldsw = (unsigned)wid * 1024u;
    const int aoff = lds_byte(wr * 64 + fr, fq * 8), boff = lds_byte(wc * 32 + fr, fq * 8);
#define PG8_SA(b, h) (((b) * 2 + (h)) * HTB)
#define PG8_SB(b, h) ((4 + (b) * 2 + (h)) * HTB)
#define PG8_STAGE(bufoff, gbase, voff) do { _Pragma("unroll") for (int _i = 0; _i < 2; ++_i) \
        __builtin_amdgcn_global_load_lds((const unsigned*)((const char*)(gbase) + (voff)[_i]), (PG8_LAS unsigned*)(lds + (bufoff) + ldsw + _i * 8192), 16, 0, 0); } while (0)
#define PG8_LDA(dst, b, h) do { _Pragma("unroll") for (int m = 0; m < 4; ++m) _Pragma("unroll") for (int k = 0; k < 2; ++k) dst[m][k] = *(const PG8_LAS bf16x8*)(lds + PG8_SA(b, h) + aoff + m * 2048 + k * 1024); } while (0)
#define PG8_LDB(dst, b, h) do { _Pragma("unroll") for (int n = 0; n < 2; ++n) _Pragma("unroll") for (int k = 0; k < 2; ++k) dst[n][k] = *(const PG8_LAS bf16x8*)(lds + PG8_SB(b, h) + boff + n * 2048 + k * 1024); } while (0)
#define PG8_MMA(ai, bj, At, Bt) do { __builtin_amdgcn_s_setprio(1); _Pragma("unroll") for (int m = 0; m < 4; ++m) _Pragma("unroll") for (int n = 0; n < 2; ++n) _Pragma("unroll") for (int k = 0; k < 2; ++k) \
        acc[ai][bj][m][n] = __builtin_amdgcn_mfma_f32_16x16x32_bf16(Bt[n][k], At[m][k], acc[ai][bj][m][n], 0, 0, 0); __builtin_amdgcn_s_setprio(0); } while (0)
#define PG8_WAIT_V(n) asm volatile("s_waitcnt vmcnt(" #n ")" ::: "memory")
#define PG8_WAIT_L(n) asm volatile("s_waitcnt lgkmcnt(" #n ")" ::: "memory")
#define PG8_BAR __builtin_amdgcn_s_barrier()
#define PG8_SCHED __builtin_amdgcn_sched_barrier(0)
    Unit cur, nxt; int ui = 0;
    if (!S.next(0, cur)) return;
    f32x4 acc[2][2][4][2];
#pragma unroll
    for (int a = 0; a < 2; ++a)
#pragma unroll
        for (int b = 0; b < 2; ++b)
#pragma unroll
            for (int m = 0; m < 4; ++m)
#pragma unroll
                for (int n = 0; n < 2; ++n) acc[a][b][m][n] = (f32x4){0.f, 0.f, 0.f, 0.f};
    bf16x8 At[4][2], B0[2][2], B1[2][2];
    const char* cA = (const char*)g.A + (size_t)cur.pm * tstep; const char* cB = (const char*)g.Bt + (size_t)cur.pn * tstep;
    S.a_ready(cur);
    if constexpr (SP2) {
        PG8_STAGE(PG8_SB(0, 0), cB, voffB); PG8_STAGE(PG8_SB(0, 1), cB + hstep, voffB); PG8_STAGE(PG8_SA(0, 0), cA, voffA); PG8_STAGE(PG8_SA(0, 1), cA + hstep, voffA);
        if (wr == 1) PG8_BAR;
        PG8_WAIT_V(2); PG8_BAR;
        PG8_STAGE(PG8_SB(1, 0), cB + kstep, voffB); PG8_STAGE(PG8_SA(1, 0), cA + kstep, voffA); PG8_STAGE(PG8_SB(1, 1), cB + hstep + kstep, voffB);
        PG8_WAIT_V(6); PG8_BAR;
    } else {
        PG8_STAGE(PG8_SB(0, 0), cB, voffB); PG8_STAGE(PG8_SA(0, 0), cA, voffA); PG8_STAGE(PG8_SB(0, 1), cB + hstep, voffB); PG8_STAGE(PG8_SA(0, 1), cA + hstep, voffA);
        if (wr == 1) PG8_BAR;
        PG8_WAIT_V(4); PG8_BAR;
        PG8_STAGE(PG8_SB(1, 0), cB + kstep, voffB); PG8_STAGE(PG8_SA(1, 0), cA + kstep, voffA); PG8_STAGE(PG8_SB(1, 1), cB + hstep + kstep, voffB);
        PG8_WAIT_V(6); PG8_BAR;
    }
    for (;;) {
        const bool has_next = S.next(ui + 1, nxt);
        const char* nA = has_next ? (const char*)g.A + (size_t)nxt.pm * tstep : cA; const char* nB = has_next ? (const char*)g.Bt + (size_t)nxt.pn * tstep : cB;
        for (int t = 0; t < nt; t += 2) {
            const bool last = (t == nt - 2);
            if constexpr (Epi::HAS_MID) { if (t == (nt >> 1)) E.mid(acc, cur, wr, wc, fr, fq); }
            const char* a1 = cA + (size_t)(t + 1) * kstep;
            const char* a2 = last ? nA : cA + (size_t)(t + 2) * kstep; const char* b2 = last ? nB : cB + (size_t)(t + 2) * kstep;
            const char* a3 = a2 + kstep; const char* b3 = b2 + kstep;
            if (last && has_next) S.a_ready(nxt);
            if constexpr (SP2) {
            PG8_LDB(B0, 0, 0); PG8_LDB(B1, 0, 1); PG8_SCHED; PG8_LDA(At, 0, 0); PG8_STAGE(PG8_SA(1, 1), a1 + hstep, voffA);
            PG8_WAIT_V(8); PG8_WAIT_L(0); PG8_BAR; PG8_MMA(0, 0, At, B0); PG8_MMA(0, 1, At, B1); PG8_BAR; PG8_SCHED;
            PG8_LDA(At, 0, 1); PG8_STAGE(PG8_SB(0, 0), b2, voffB); PG8_STAGE(PG8_SB(0, 1), b2 + hstep, voffB); PG8_STAGE(PG8_SA(0, 0), a2, voffA);
            PG8_WAIT_V(8); PG8_WAIT_L(0); PG8_BAR; PG8_MMA(1, 0, At, B0); PG8_MMA(1, 1, At, B1); PG8_BAR; PG8_SCHED;
            PG8_LDB(B0, 1, 0); PG8_LDB(B1, 1, 1); PG8_SCHED; PG8_LDA(At, 1, 0); PG8_STAGE(PG8_SA(0, 1), a2 + hstep, voffA);
            PG8_WAIT_V(8); PG8_WAIT_L(0); PG8_BAR; PG8_MMA(0, 0, At, B0); PG8_MMA(0, 1, At, B1); PG8_BAR; PG8_SCHED;
            PG8_LDA(At, 1, 1); PG8_STAGE(PG8_SB(1, 0), b3, voffB); PG8_STAGE(PG8_SB(1, 1), b3 + hstep, voffB); PG8_STAGE(PG8_SA(1, 0), a3, voffA);
            PG8_WAIT_V(8); PG8_WAIT_L(0); PG8_BAR; PG8_MMA(1, 0, At, B0); PG8_MMA(1, 1, At, B1); PG8_BAR; PG8_SCHED;
            } else {
            PG8_LDB(B0, 0, 0); PG8_SCHED; PG8_LDA(At, 0, 0); PG8_STAGE(PG8_SA(1, 1), a1 + hstep, voffA);
            PG8_WAIT_L(8); PG8_BAR; PG8_WAIT_L(0); PG8_MMA(0, 0, At, B0); PG8_BAR; PG8_SCHED;
            PG8_LDB(B1, 0, 1); PG8_STAGE(PG8_SB(0, 0), b2, voffB);
            PG8_BAR; PG8_WAIT_L(0); PG8_MMA(0, 1, At, B1); PG8_BAR;
            PG8_LDA(At, 0, 1); PG8_STAGE(PG8_SA(0, 0), a2, voffA);
            PG8_BAR; PG8_WAIT_L(0); PG8_MMA(1, 0, At, B0); PG8_BAR; PG8_SCHED;
            PG8_STAGE(PG8_SB(0, 1), b2 + hstep, voffB);
            PG8_WAIT_V(6); PG8_BAR; PG8_MMA(1, 1, At, B1); PG8_BAR;
            PG8_LDB(B0, 1, 0); PG8_SCHED; PG8_LDA(At, 1, 0); PG8_STAGE(PG8_SA(0, 1), a2 + hstep, voffA);
            PG8_WAIT_L(8); PG8_BAR; PG8_WAIT_L(0); PG8_MMA(0, 0, At, B0); PG8_BAR; PG8_SCHED;
            PG8_LDB(B1, 1, 1); PG8_STAGE(PG8_SB(1, 0), b3, voffB);
            PG8_BAR; PG8_WAIT_L(0); PG8_MMA(0, 1, At, B1); PG8_BAR;
            PG8_LDA(At, 1, 1); PG8_STAGE(PG8_SA(1, 0), a3, voffA);
            PG8_BAR; PG8_WAIT_L(0); PG8_MMA(1, 0, At, B0); PG8_BAR; PG8_SCHED;
            PG8_STAGE(PG8_SB(1, 1), b3 + hstep, voffB);
            PG8_WAIT_V(6); PG8_BAR; PG8_MMA(1, 1, At, B1); PG8_BAR;
            }
        }
        if constexpr (ALIGN_EPI) { if (wr == 0) PG8_BAR; }
        if constexpr (!Epi::AFTER_DRAIN) { E(acc, cur, wr, wc, fr, fq); S.done(cur); }
        if (!has_next) break;
#pragma unroll
        for (int a = 0; a < 2; ++a)
#pragma unroll
            for (int b = 0; b < 2; ++b)
#pragma unroll
                for (int m = 0; m < 4; ++m)
#pragma unroll
                    for (int n = 0; n < 2; ++n) acc[a][b][m][n] = (f32x4){0.f, 0.f, 0.f, 0.f};
        cur = nxt; cA = nA; cB = nB; ++ui;
        if constexpr (ALIGN_EPI) { if (wr == 1) PG8_BAR; }
    }
    PG8_WAIT_V(0);
    if constexpr (!ALIGN_EPI) { if (wr == 0) PG8_BAR; }
    PG8_BAR;
    if constexpr (Epi::AFTER_DRAIN) { E.fused(acc, cur, wr, wc, fr, fq, lds, wid, lane); S.done(cur); }
#undef PG8_SA
#undef PG8_SB
#undef PG8_STAGE
#undef PG8_LDA
#undef PG8_LDB
#undef PG8_MMA
#undef PG8_WAIT_V
#undef PG8_WAIT_L
#undef PG8_BAR
#undef PG8_SCHED
}
}
#ifndef PG8_SP2
#define PG8_SP2 true
#endif
#ifndef PG8_ALIGN
#define PG8_ALIGN true
#endif
#ifndef MK_N_LAUNCHES
#define MK_N_LAUNCHES 1
#endif
constexpr int NWAVES = 8, NTHR = 512;
constexpr int BATCH = 4, SEQ = 8192, DM = 2048, M = BATCH * SEQ, NH = 8, HD = 128;
constexpr int FFH = 5632, INW = 11264, ZP = 9216, NBLK = 32, MB = 256;
constexpr int ZC_QA = 0, ZC_KA = 1024, ZC_QB = 2048, ZC_FB = 3072, ZC_OG = 4096, ZC_GA = 5120, ZC_GB = 7168;
constexpr float LN_EPS = 1e-5f, RMS_EPS = 1e-6f, ALPHA = 1.189207115002721f;
constexpr int NPHASE = 13;
constexpr size_t MiB = 1u << 20;
constexpr size_t WS_WIN = 1 * MiB, WS_WP = 45 * MiB, WS_WO = 53 * MiB, WS_WGU = 61 * MiB, WS_WD = 105 * MiB;
constexpr size_t WS_XB = 128 * MiB;
constexpr size_t WS_Z = 256 * MiB;
constexpr size_t WS_VT = 832 * MiB;
constexpr size_t WS_KMH = 960 * MiB, WS_KML = 961 * MiB, WS_DC = 962 * MiB, WS_STATS = 965 * MiB, WS_CNT = 966 * MiB, WS_BAR = 967 * MiB, WS_LIST = 968 * MiB, WS_PML = 1000 * MiB, WS_END = 1008 * MiB;
constexpr size_t WS_PRE1 = WS_Z, WS_ACT = WS_Z + 256 * MiB, WS_MERGED = WS_VT, WS_OAB = WS_XB, WS_H1N = WS_XB;
constexpr int LDS_BYTES = 147456;

#define LAS __attribute__((address_space(3)))
typedef unsigned short bf16;
typedef unsigned v4u __attribute__((ext_vector_type(4)));
typedef unsigned v2u __attribute__((ext_vector_type(2)));
typedef float f32x4 __attribute__((ext_vector_type(4)));
typedef float f32x2 __attribute__((ext_vector_type(2)));
typedef float f32x16 __attribute__((ext_vector_type(16)));
typedef short bf16x8 __attribute__((ext_vector_type(8)));
typedef short s16x4 __attribute__((ext_vector_type(4)));
#define LDS_WAIT() asm volatile("s_waitcnt lgkmcnt(0)" ::: "memory")
#define LDS_BARRIER() asm volatile("s_waitcnt lgkmcnt(0)\n\ts_barrier" ::: "memory")
using pg8::cvt_pk_bf16; using pg8::bf_lo; using pg8::bf_hi; using pg8::sigm;
__device__ __forceinline__ float bf2f(bf16 b) { return __uint_as_float((unsigned)b << 16); }
__device__ __forceinline__ float ex2(float x) { return __builtin_amdgcn_exp2f(x); }
__device__ __forceinline__ float lg2(float x) { return __builtin_amdgcn_logf(x); }
__device__ __forceinline__ int crow(int r, int hi) { return (r & 3) + 8 * (r >> 2) + 4 * hi; }
__device__ __forceinline__ float wave_sum(float v) {
#pragma unroll
    for (int o = 1; o < 64; o <<= 1) v += __shfl_xor(v, o);
    return v;
}

struct Frame { LAS unsigned char* lds; int tid, lane, wave, G, bid; };

__device__ __forceinline__ void transpose_item(const float* W, int N, bf16* WT, size_t dpitch, int dst_row0, int dst_k0, int k0, int n0, LAS float* scr, int lane) {
#pragma unroll 8
    for (int i = 0; i < 32; ++i) { const int kk = 2 * i + (lane >> 5); scr[kk * 33 + (lane & 31)] = W[(size_t)(k0 + kk) * N + n0 + (lane & 31)]; }
    LDS_WAIT(); asm volatile("" ::: "memory");
    const int c = lane & 7;
#pragma unroll
    for (int j = 0; j < 4; ++j) { const int n = (lane >> 3) + 8 * j; const LAS float* s = scr + (8 * c) * 33 + n;
        v4u o; o.x = cvt_pk_bf16(s[0 * 33], s[1 * 33]); o.y = cvt_pk_bf16(s[2 * 33], s[3 * 33]); o.z = cvt_pk_bf16(s[4 * 33], s[5 * 33]); o.w = cvt_pk_bf16(s[6 * 33], s[7 * 33]);
        *(v4u*)(WT + (size_t)(dst_row0 + n) * dpitch + dst_k0 + k0 + 8 * c) = o; }
    LDS_WAIT(); asm volatile("" ::: "memory");
}
__device__ __forceinline__ int win_dst_row(int n) {
    if (n < 2048) return n;
    if (n < 3072) return 9216 + (n - 2048);
    if (n < 5120) return n - 1024;
    if (n < 6144) return 9216 + 1024 + (n - 5120);
    return n - 2048;
}
__device__ __forceinline__ void p0_prologue(const Frame& F, const float* const* in, unsigned char* ws) {
    LAS float* scr = (LAS float*)(F.lds + F.wave * 16384);
    const int gw = F.bid * NWAVES + F.wave, NGW = F.G * NWAVES;
    constexpr int I_IN = 32 * 352, I_P = 16 * 64, I_WO = 32 * 64, I_G = 32 * 176, I_D = 88 * 64;
    constexpr int NITEMS = I_IN + 2 * I_P + I_WO + 2 * I_G + I_D;
    bf16* WIN = (bf16*)(ws + WS_WIN); bf16* WP = (bf16*)(ws + WS_WP); bf16* WO = (bf16*)(ws + WS_WO); bf16* WGU = (bf16*)(ws + WS_WGU); bf16* WD = (bf16*)(ws + WS_WD);
    for (int it = gw; it < NITEMS; it += NGW) {
        int r = it;
        if (r < I_IN) { const int kb = r / 352, nb = r % 352; transpose_item(in[1], INW, WIN, 2048, win_dst_row(32 * nb), 0, 64 * kb, 32 * nb, scr, F.lane); continue; } r -= I_IN;
        if (r < I_P) { const int kb = r / 64, nb = r % 64; transpose_item(in[2], 2048, WP, 2048, 32 * nb, 0, 64 * kb, 32 * nb, scr, F.lane); continue; } r -= I_P;
        if (r < I_P) { const int kb = r / 64, nb = r % 64; transpose_item(in[3], 2048, WP, 2048, 32 * nb, 1024, 64 * kb, 32 * nb, scr, F.lane); continue; } r -= I_P;
        if (r < I_WO) { const int kb = r / 64, nb = r % 64; transpose_item(in[4], 2048, WO, 2048, 32 * nb, 0, 64 * kb, 32 * nb, scr, F.lane); continue; } r -= I_WO;
        if (r < I_G) { const int kb = r / 176, nb = r % 176, n0 = 32 * nb; transpose_item(in[9], FFH, WGU, 2048, (n0 >> 7) * 256 + (n0 & 127), 0, 64 * kb, n0, scr, F.lane); continue; } r -= I_G;
        if (r < I_G) { const int kb = r / 176, nb = r % 176, n0 = 32 * nb; transpose_item(in[10], FFH, WGU, 2048, (n0 >> 7) * 256 + 128 + (n0 & 127), 0, 64 * kb, n0, scr, F.lane); continue; } r -= I_G;
        { const int kb = r / 64, nb = r % 64; transpose_item(in[11], 2048, WD, FFH, 32 * nb, 0, 64 * kb, 32 * nb, scr, F.lane); }
    }
    const f32x4* x4 = (const f32x4*)in[0]; v4u* xb = (v4u*)(ws + WS_XB);
    for (size_t i = (size_t)F.bid * NTHR + F.tid; i < (size_t)M * DM / 8; i += (size_t)F.G * NTHR) {
        const f32x4 a = x4[2 * i], b = x4[2 * i + 1];
        v4u o; o.x = cvt_pk_bf16(a[0], a[1]); o.y = cvt_pk_bf16(a[2], a[3]); o.z = cvt_pk_bf16(b[0], b[1]); o.w = cvt_pk_bf16(b[2], b[3]);
        xb[i] = o;
    }
}

__device__ __forceinline__ void kmean_item(const Frame& F, int item, const bf16* Z, bf16* KMH, bf16* KML) {
    const int bh = item >> 5, j = item & 31, b = bh >> 3, h = bh & 7;
    LAS float* red = (LAS float*)F.lds;
    const int dp = F.tid & 63, rg = F.tid >> 6;
    const bf16* kp = Z + ((size_t)b * SEQ + 256 * j + 32 * rg) * ZP + ZC_KA + h * HD + 2 * dp;
    float s0 = 0.f, s1 = 0.f;
#pragma unroll 8
    for (int r = 0; r < 32; ++r) { const unsigned w = *(const unsigned*)(kp + (size_t)r * ZP); s0 += bf_lo(w); s1 += bf_hi(w); }
    red[rg * 128 + 2 * dp] = s0; red[rg * 128 + 2 * dp + 1] = s1;
    __syncthreads();
    if (F.tid < 128) { float t = 0.f;
#pragma unroll
        for (int g = 0; g < 8; ++g) t += red[g * 128 + F.tid];
        t *= (1.f / 256.f);
        const unsigned hi = cvt_pk_bf16(t, 0.f) & 0xffffu; const float hf = __uint_as_float(hi << 16);
        const unsigned lo = cvt_pk_bf16(t - hf, 0.f) & 0xffffu;
        KMH[(size_t)item * 128 + F.tid] = (bf16)hi; KML[(size_t)item * 128 + F.tid] = (bf16)lo; }
    __syncthreads();
}
constexpr int HQ_P = 136, HK_P = 72;
constexpr int H_QS = 0, H_KH = 17408, H_KT = 34816, H_VT = 53248, H_DEC = 71680, H_OS = 73728, OS_P = 132;
#define MFMA16K32(a, b, c) __builtin_amdgcn_mfma_f32_16x16x32_bf16((a), (b), (c), 0, 0, 0)
__device__ __forceinline__ f32x4 mfma16k16_pad(s16x4 a, s16x4 b, f32x4 c) {
    const bf16x8 a8 = {a[0], a[1], a[2], a[3], 0, 0, 0, 0}, b8 = {b[0], b[1], b[2], b[3], 0, 0, 0, 0};
    return __builtin_amdgcn_mfma_f32_16x16x32_bf16(a8, b8, c, 0, 0, 0);
}
#define MFMA16K16(a, b, c) mfma16k16_pad((a), (b), (c))
constexpr int HSEG = 16;
template <bool OUT>
__device__ __forceinline__ void hgrn_item(const Frame& F, int item, const bf16* Z, const bf16* VT, const float* lbl, float* ST, float* DC, const float* normg, bf16* OAB) {
    const int bh = item >> 3, sg = item & 7, b = bh >> 3, h = bh & 7;
    const int l15 = F.lane & 15, g = F.lane >> 4, w = F.wave;
    f32x4 S[8];
    f32x4* stp = (f32x4*)ST + ((size_t)item * 64 + w * 8) * 64 + F.lane;
    if (OUT) {
#pragma unroll
        for (int kp = 0; kp < 8; ++kp) S[kp] = stp[kp * 64];
    } else {
#pragma unroll
        for (int kp = 0; kp < 8; ++kp) S[kp] = (f32x4){0.f, 0.f, 0.f, 0.f};
    }
    float dtot = 1.f;
    const int ak = F.tid & 127, aj = F.tid >> 7;
    const float lb = sigm(lbl[h * 128 + ak] - lbl[1024 + h * 128 + ak]);
    unsigned short fraw[16], qraw[16]; v4u vraw[2];
#define HG_LOAD(c_) do { const size_t r0_ = (size_t)b * SEQ + 64 * (c_); \
        const bf16* zq_ = Z + (r0_ + 16 * aj) * ZP + ZC_QB + h * HD + ak; const bf16* zf_ = Z + (r0_ + 16 * aj) * ZP + ZC_FB + h * HD + ak; \
        _Pragma("unroll") for (int i = 0; i < 16; ++i) { fraw[i] = zf_[(size_t)i * ZP]; if (OUT) qraw[i] = zq_[(size_t)i * ZP]; } \
        _Pragma("unroll") for (int i = 0; i < 2; ++i) { const int idx = F.tid + 512 * i; vraw[i] = *(const v4u*)(VT + (size_t)(1024 + h * HD + (idx >> 3)) * M + r0_ + 8 * (idx & 7)); } } while (0)
    HG_LOAD(sg * HSEG);
    const int et = F.tid >> 3, eseg = F.tid & 7;
    f32x4 n0, n1, n2, n3;
    { const float* ng = normg + h * HD + 16 * eseg; n0 = *(const f32x4*)ng; n1 = *(const f32x4*)(ng + 4); n2 = *(const f32x4*)(ng + 8); n3 = *(const f32x4*)(ng + 12); }
#pragma unroll 1
  for (int cc = 0; cc < HSEG; ++cc) {
    const int c = sg * HSEG + cc;
    const size_t row0 = (size_t)b * SEQ + 64 * c;
    LAS bf16* Qs = (LAS bf16*)(F.lds + H_QS); LAS bf16* Kh = (LAS bf16*)(F.lds + H_KH); LAS bf16* Kt = (LAS bf16*)(F.lds + H_KT); LAS bf16* Vt = (LAS bf16*)(F.lds + H_VT);
    LAS float* dec = (LAS float*)(F.lds + H_DEC); LAS float* Os = (LAS float*)(F.lds + H_OS);
    {
        const int k = ak, j = aj;
        float bl[16], ky[16]; float a2 = 0.f;
#pragma unroll
        for (int i = 0; i < 16; ++i) {
            const float fl = bf2f(fraw[i]);
            const float sg_ = sigm(fl), f = lb + (1.f - lb) * sg_;
            a2 += lg2(f); bl[i] = a2; ky[i] = (1.f - lb) * (1.f - sg_);
            if (OUT) {
                const float qv = bf2f(qraw[i]);
                const float ea = ex2(a2);
                const float qt = qv * sigm(qv) * ea, kh = ky[i] * ex2(-a2);
                Qs[(16 * j + i) * HQ_P + k] = (bf16)(cvt_pk_bf16(qt, 0.f) & 0xffffu);
                Kh[(16 * j + i) * HQ_P + k] = (bf16)(cvt_pk_bf16(kh, 0.f) & 0xffffu);
            }
        }
        v4u w0, w1;
        w0.x = cvt_pk_bf16(ky[0] * ex2(a2 - bl[0]), ky[1] * ex2(a2 - bl[1]));     w0.y = cvt_pk_bf16(ky[2] * ex2(a2 - bl[2]), ky[3] * ex2(a2 - bl[3]));
        w0.z = cvt_pk_bf16(ky[4] * ex2(a2 - bl[4]), ky[5] * ex2(a2 - bl[5]));     w0.w = cvt_pk_bf16(ky[6] * ex2(a2 - bl[6]), ky[7] * ex2(a2 - bl[7]));
        w1.x = cvt_pk_bf16(ky[8] * ex2(a2 - bl[8]), ky[9] * ex2(a2 - bl[9]));     w1.y = cvt_pk_bf16(ky[10] * ex2(a2 - bl[10]), ky[11] * ex2(a2 - bl[11]));
        w1.z = cvt_pk_bf16(ky[12] * ex2(a2 - bl[12]), ky[13] * ex2(a2 - bl[13])); w1.w = cvt_pk_bf16(ky[14] * ex2(a2 - bl[14]), ky[15] * ex2(a2 - bl[15]));
        *(LAS v4u*)(Kt + k * HK_P + 16 * j) = w0; *(LAS v4u*)(Kt + k * HK_P + 16 * j + 8) = w1;
        dec[j * 128 + k] = ex2(a2);
#pragma unroll
        for (int i = 0; i < 2; ++i) { const int idx = F.tid + 512 * i, v = idx >> 3, c8 = idx & 7;
            *(LAS v4u*)(Vt + v * HK_P + 8 * c8) = vraw[i]; }
    }
    v4u g0 = {0u, 0u, 0u, 0u}, g1 = {0u, 0u, 0u, 0u};
    if (OUT) { const bf16* og = Z + (row0 + et) * ZP + ZC_OG + h * HD + 16 * eseg; g0 = *(const v4u*)og; g1 = *(const v4u*)(og + 8); }
    LDS_BARRIER();
    if (cc + 1 < HSEG) HG_LOAD(c + 1);
#pragma unroll
    for (int j = 0; j < 4; ++j) {
        const s16x4 vf = *(const LAS s16x4*)(Vt + (16 * w + l15) * HK_P + 16 * j + 4 * g);
        if (OUT) {
            f32x4 at = (f32x4){0.f, 0.f, 0.f, 0.f};
#pragma unroll
            for (int kk = 0; kk < 4; ++kk) {
                const bf16x8 a = *(const LAS bf16x8*)(Kh + (16 * j + l15) * HQ_P + 32 * kk + 8 * g);
                const bf16x8 q = *(const LAS bf16x8*)(Qs + (16 * j + l15) * HQ_P + 32 * kk + 8 * g);
                at = MFMA16K32(a, q, at);
            }
#pragma unroll
            for (int i = 0; i < 4; ++i) if (4 * g + i > l15) at[i] = 0.f;
            v2u atp; atp.x = cvt_pk_bf16(at[0], at[1]); atp.y = cvt_pk_bf16(at[2], at[3]);
            const s16x4 atb = __builtin_bit_cast(s16x4, atp);
            f32x4 o = (f32x4){0.f, 0.f, 0.f, 0.f};
#pragma unroll
            for (int kk = 0; kk < 4; ++kk) {
                const v2u qa = *(const LAS v2u*)(Qs + (16 * j + l15) * HQ_P + 32 * kk + 4 * g);
                const v2u qb = *(const LAS v2u*)(Qs + (16 * j + l15) * HQ_P + 32 * kk + 16 + 4 * g);
                v4u av; av.x = qa.x; av.y = qa.y; av.z = qb.x; av.w = qb.y;
                v4u bv; bv.x = cvt_pk_bf16(S[2 * kk][0], S[2 * kk][1]); bv.y = cvt_pk_bf16(S[2 * kk][2], S[2 * kk][3]);
                bv.z = cvt_pk_bf16(S[2 * kk + 1][0], S[2 * kk + 1][1]); bv.w = cvt_pk_bf16(S[2 * kk + 1][2], S[2 * kk + 1][3]);
                o = MFMA16K32(__builtin_bit_cast(bf16x8, av), __builtin_bit_cast(bf16x8, bv), o);
            }
            o = MFMA16K16(atb, vf, o);
#pragma unroll
            for (int i = 0; i < 4; ++i) Os[(16 * j + 4 * g + i) * OS_P + 16 * w + l15] = o[i];
        }
#pragma unroll
        for (int kp = 0; kp < 8; ++kp) {
            const f32x4 d = *(const LAS f32x4*)(dec + j * 128 + 16 * kp + 4 * g);
            const s16x4 kf = *(const LAS s16x4*)(Kt + (16 * kp + l15) * HK_P + 16 * j + 4 * g);
            S[kp] = MFMA16K16(kf, vf, S[kp] * d);
        }
    }
    if (!OUT) {
        if (F.tid < 128) dtot *= dec[F.tid] * dec[128 + F.tid] * dec[256 + F.tid] * dec[384 + F.tid];
    } else {
        LDS_BARRIER();
        const int t = et, seg = eseg;
        f32x4 x[4]; float ss = 0.f;
#pragma unroll
        for (int i = 0; i < 4; ++i) { x[i] = *(const LAS f32x4*)(Os + t * OS_P + 16 * seg + 4 * i); ss += (x[i][0] * x[i][0] + x[i][1] * x[i][1]) + (x[i][2] * x[i][2] + x[i][3] * x[i][3]); }
        ss += __shfl_xor(ss, 1); ss += __shfl_xor(ss, 2); ss += __shfl_xor(ss, 4);
        const float rstd = __builtin_amdgcn_rsqf(ss * (1.f / 128.f) + RMS_EPS);
        v4u o0, o1;
        o0.x = cvt_pk_bf16(x[0][0] * rstd * n0[0] * sigm(bf_lo(g0.x)), x[0][1] * rstd * n0[1] * sigm(bf_hi(g0.x)));
        o0.y = cvt_pk_bf16(x[0][2] * rstd * n0[2] * sigm(bf_lo(g0.y)), x[0][3] * rstd * n0[3] * sigm(bf_hi(g0.y)));
        o0.z = cvt_pk_bf16(x[1][0] * rstd * n1[0] * sigm(bf_lo(g0.z)), x[1][1] * rstd * n1[1] * sigm(bf_hi(g0.z)));
        o0.w = cvt_pk_bf16(x[1][2] * rstd * n1[2] * sigm(bf_lo(g0.w)), x[1][3] * rstd * n1[3] * sigm(bf_hi(g0.w)));
        o1.x = cvt_pk_bf16(x[2][0] * rstd * n2[0] * sigm(bf_lo(g1.x)), x[2][1] * rstd * n2[1] * sigm(bf_hi(g1.x)));
        o1.y = cvt_pk_bf16(x[2][2] * rstd * n2[2] * sigm(bf_lo(g1.y)), x[2][3] * rstd * n2[3] * sigm(bf_hi(g1.y)));
        o1.z = cvt_pk_bf16(x[3][0] * rstd * n3[0] * sigm(bf_lo(g1.z)), x[3][1] * rstd * n3[1] * sigm(bf_hi(g1.z)));
        o1.w = cvt_pk_bf16(x[3][2] * rstd * n3[2] * sigm(bf_lo(g1.w)), x[3][3] * rstd * n3[3] * sigm(bf_hi(g1.w)));
        bf16* op = OAB + (row0 + t) * DM + 1024 + h * HD + 16 * seg;
        *(v4u*)op = o0; *(v4u*)(op + 8) = o1;
    }
    LDS_BARRIER();
  }
    if (!OUT) {
#pragma unroll
        for (int kp = 0; kp < 8; ++kp) stp[kp * 64] = S[kp];
        if (F.tid < 128) DC[(size_t)item * 128 + F.tid] = dtot;
    }
}
__device__ __forceinline__ void hgrn_scan(const Frame& F, float* ST, const float* DC) {
    for (int gid = F.bid * NTHR + F.tid; gid < 32 * 4096; gid += F.G * NTHR) {
        const int bh = gid >> 12, q = gid & 4095, kp = (q >> 6) & 7, ln = q & 63, k0 = 16 * kp + 4 * (ln >> 4);
        f32x4* sp = (f32x4*)ST + (size_t)bh * 8 * 4096 + q; const f32x4* dp = (const f32x4*)(DC + (size_t)bh * 8 * 128 + k0);
        f32x4 s = (f32x4){0.f, 0.f, 0.f, 0.f};
#pragma unroll
        for (int c = 0; c < 8; ++c) { const f32x4 u = sp[(size_t)c * 4096]; const f32x4 d = dp[c * 32]; sp[(size_t)c * 4096] = s; s = d * s + u; }
    }
}
constexpr int AK_P = 136, AV_P = 72;
constexpr int A_QS = 71680;
constexpr int A_KS = 0, A_VS = 2 * 64 * AK_P * 2  , A_KSZ = 64 * AK_P * 2, A_VSZ = 128 * AV_P * 2;
#define MFMA32(a, b, c) __builtin_amdgcn_mfma_f32_32x32x16_bf16((a), (b), (c), 0, 0, 0)
__device__ __forceinline__ void attn_unit(const Frame& F, int bh, int n, const bf16* Z, const bf16* VT, const bf16* KMH, const bf16* KML, bf16* OAB) {
    const int b = bh >> 3, h = bh & 7, w = F.wave, q32 = F.lane & 31, hi = F.lane >> 5;
    const size_t rowb = (size_t)b * SEQ;
    const int qpos = 32 * w + q32;
    constexpr float C2 = 0.08838834764831845f * 1.4426950408889634f;
    constexpr float NEG = -1e30f;
    bf16x8 qr[8];
    { const bf16* qp = Z + (rowb + 256 * n + qpos) * ZP + ZC_QA + h * HD + 8 * hi;
#pragma unroll
      for (int s = 0; s < 8; ++s) qr[s] = *(const bf16x8*)(qp + 16 * s); }
    unsigned bmask = 0u;
    if (n > 0) {
        f32x16 gt = {};
        const bf16* kh = KMH + ((size_t)bh * 32 + q32) * 128 + 8 * hi; const bf16* kl = KML + ((size_t)bh * 32 + q32) * 128 + 8 * hi;
#pragma unroll
        for (int s = 0; s < 8; ++s) { const bf16x8 a = *(const bf16x8*)(kh + 16 * s), a2 = *(const bf16x8*)(kl + 16 * s); gt = MFMA32(a, qr[s], gt); gt = MFMA32(a2, qr[s], gt); }
        float gv[16];
#pragma unroll
        for (int r = 0; r < 16; ++r) gv[r] = (crow(r, hi) < n) ? gt[r] : -INFINITY;
#pragma unroll
        for (int round = 0; round < 3; ++round) {
            float bv = -INFINITY; int bj = 99;
#pragma unroll
            for (int r = 0; r < 16; ++r) if (gv[r] > bv) { bv = gv[r]; bj = crow(r, hi); }
            const float pv = __shfl_xor(bv, 32); const int pj = __shfl_xor(bj, 32);
            const bool mine = (bv > pv) || (bv == pv && bj < pj);
            const float wv = mine ? bv : pv; const int wj = mine ? bj : pj;
            if (wv > -INFINITY) bmask |= 1u << wj;
            if (mine) {
#pragma unroll
                for (int r = 0; r < 16; ++r) if (crow(r, hi) == bj) gv[r] = -INFINITY;
            }
        }
    }
    LAS bf16x8* qs = (LAS bf16x8*)(F.lds + A_QS) + (w * 8) * 64 + F.lane;
#pragma unroll
    for (int s = 0; s < 8; ++s) qs[s * 64] = qr[s];
    f32x16 O[4]; O[0] = f32x16{}; O[1] = f32x16{}; O[2] = f32x16{}; O[3] = f32x16{};
    float mrow = NEG, lrow = 0.f;
    const int NT = 4 + 4 * n;
    const bf16* Kg = Z + rowb * ZP + ZC_KA + h * HD;
    const bf16* Vg = VT + (size_t)(h * HD) * M + rowb;
    v4u kst[2], vst[2];
#define A_LOAD(t_) do { const int kr0_ = ((t_) < 4) ? 256 * n + 64 * (t_) : 64 * ((t_) - 4); \
        _Pragma("unroll") for (int i_ = 0; i_ < 2; ++i_) { const int idx_ = F.tid + 512 * i_; \
            kst[i_] = *(const v4u*)(Kg + (size_t)(kr0_ + (idx_ >> 4)) * ZP + 8 * (idx_ & 15)); \
            vst[i_] = *(const v4u*)(Vg + (size_t)(idx_ >> 3) * M + kr0_ + 8 * (idx_ & 7)); } } while (0)
#define A_STORE(buf_) do { _Pragma("unroll") for (int i_ = 0; i_ < 2; ++i_) { const int idx_ = F.tid + 512 * i_; \
            *(LAS v4u*)(F.lds + A_KS + (buf_) * A_KSZ + ((idx_ >> 4) * AK_P + 8 * (idx_ & 15)) * 2) = kst[i_]; \
            *(LAS v4u*)(F.lds + A_VS + (buf_) * A_VSZ + ((idx_ >> 3) * AV_P + 8 * (idx_ & 7)) * 2) = vst[i_]; } } while (0)
    A_LOAD(0); A_STORE(0);
    __syncthreads();
    for (int t = 0; t < NT; ++t) {
        const int buf = t & 1;
        if (t + 1 < NT) A_LOAD(t + 1);
        bool need; int jblk = 0;
        if (t < 4) need = (64 * t <= 32 * w + 31);
        else { jblk = (t - 4) >> 2; need = __ballot((bmask >> jblk) & 1u) != 0ull; }
        if (need) {
            const LAS unsigned char* Kb = F.lds + A_KS + buf * A_KSZ; const LAS unsigned char* Vb = F.lds + A_VS + buf * A_VSZ;
            f32x16 p0 = {}, p1 = {};
#pragma unroll
            for (int s = 0; s < 8; ++s) {
                const bf16x8 a0 = *(const LAS bf16x8*)(Kb + (q32 * AK_P + 16 * s + 8 * hi) * 2);
                const bf16x8 a1 = *(const LAS bf16x8*)(Kb + ((32 + q32) * AK_P + 16 * s + 8 * hi) * 2);
                const bf16x8 qf = qs[s * 64];
                p0 = MFMA32(a0, qf, p0); p1 = MFMA32(a1, qf, p1);
            }
            if (t < 4) {
                const int kb0 = 64 * t;
#pragma unroll
                for (int r = 0; r < 16; ++r) { const int kp = kb0 + crow(r, hi);
                    p0[r] = (kp <= qpos) ? p0[r] * C2 : NEG; p1[r] = (kp + 32 <= qpos) ? p1[r] * C2 : NEG; }
            } else {
                const bool sel = (bmask >> jblk) & 1u;
#pragma unroll
                for (int r = 0; r < 16; ++r) { p0[r] = sel ? p0[r] * C2 : NEG; p1[r] = sel ? p1[r] * C2 : NEG; }
            }
            float mt = p0[0];
#pragma unroll
            for (int r = 1; r < 16; ++r) mt = fmaxf(mt, p0[r]);
#pragma unroll
            for (int r = 0; r < 16; ++r) mt = fmaxf(mt, p1[r]);
            mt = fmaxf(mt, __shfl_xor(mt, 32));
            const float mn = fmaxf(mrow, mt), alpha = ex2(mrow - mn);
            mrow = mn;
            float ls = 0.f;
#pragma unroll
            for (int r = 0; r < 16; ++r) { p0[r] = ex2(p0[r] - mn); p1[r] = ex2(p1[r] - mn); ls += p0[r] + p1[r]; }
            lrow = lrow * alpha + ls;
#pragma unroll
            for (int d = 0; d < 4; ++d) O[d] *= alpha;
            bf16x8 pb[2][2];
#pragma unroll
            for (int s = 0; s < 2; ++s) {
                v4u x0, x1;
                x0.x = cvt_pk_bf16(p0[8 * s + 0], p0[8 * s + 1]); x0.y = cvt_pk_bf16(p0[8 * s + 2], p0[8 * s + 3]); x0.z = cvt_pk_bf16(p0[8 * s + 4], p0[8 * s + 5]); x0.w = cvt_pk_bf16(p0[8 * s + 6], p0[8 * s + 7]);
                x1.x = cvt_pk_bf16(p1[8 * s + 0], p1[8 * s + 1]); x1.y = cvt_pk_bf16(p1[8 * s + 2], p1[8 * s + 3]); x1.z = cvt_pk_bf16(p1[8 * s + 4], p1[8 * s + 5]); x1.w = cvt_pk_bf16(p1[8 * s + 6], p1[8 * s + 7]);
                pb[0][s] = __builtin_bit_cast(bf16x8, x0); pb[1][s] = __builtin_bit_cast(bf16x8, x1);
            }
#pragma unroll
            for (int d = 0; d < 4; ++d)
#pragma unroll
                for (int sub = 0; sub < 2; ++sub)
#pragma unroll
                    for (int s = 0; s < 2; ++s) {
                        const LAS unsigned char* vp = Vb + ((32 * d + q32) * AV_P + 32 * sub + 16 * s + 4 * hi) * 2;
                        const v2u lo = *(const LAS v2u*)vp, hh = *(const LAS v2u*)(vp + 16);
                        v4u av; av.x = lo.x; av.y = lo.y; av.z = hh.x; av.w = hh.y;
                        O[d] = MFMA32(__builtin_bit_cast(bf16x8, av), pb[sub][s], O[d]);
                    }
        }
        if (t + 1 < NT) A_STORE(buf ^ 1);
        __syncthreads();
    }
#undef A_LOAD
#undef A_STORE
    const float lt = lrow + __shfl_xor(lrow, 32);
    const float inv = 1.f / lt;
    bf16* op = OAB + (rowb + 256 * n + qpos) * DM + h * HD + 4 * hi;
#pragma unroll
    for (int d = 0; d < 4; ++d)
#pragma unroll
        for (int r4 = 0; r4 < 4; ++r4) {
            v2u o; o.x = cvt_pk_bf16(O[d][4 * r4] * inv, O[d][4 * r4 + 1] * inv); o.y = cvt_pk_bf16(O[d][4 * r4 + 2] * inv, O[d][4 * r4 + 3] * inv);
            *(v2u*)(op + 32 * d + 8 * r4) = o;
        }
}
constexpr int GK_P = 136, GV_P = 264;
constexpr int G_KS = 0, G_VS = 256 * GK_P * 2  , G_MISC = G_VS + 128 * GV_P * 2  ;
constexpr int N_UNITS = 32 * 32;
__device__ __forceinline__ unsigned moba_mask(const Frame& F, int bh, int n, const bf16x8 (&qr)[8], const bf16* KMH, const bf16* KML) {
    const int q32 = F.lane & 31, hi = F.lane >> 5;
    unsigned bmask = 0u;
    if (n > 0) {
        f32x16 gt = {};
        const bf16* kh = KMH + ((size_t)bh * 32 + q32) * 128 + 8 * hi; const bf16* kl = KML + ((size_t)bh * 32 + q32) * 128 + 8 * hi;
#pragma unroll
        for (int s = 0; s < 8; ++s) { const bf16x8 a = *(const bf16x8*)(kh + 16 * s), a2 = *(const bf16x8*)(kl + 16 * s); gt = MFMA32(a, qr[s], gt); gt = MFMA32(a2, qr[s], gt); }
        float gv[16];
#pragma unroll
        for (int r = 0; r < 16; ++r) gv[r] = (crow(r, hi) < n) ? gt[r] : -INFINITY;
#pragma unroll
        for (int round = 0; round < 3; ++round) {
            float bv = -INFINITY; int bj = 99;
#pragma unroll
            for (int r = 0; r < 16; ++r) if (gv[r] > bv) { bv = gv[r]; bj = crow(r, hi); }
            const float pv = __shfl_xor(bv, 32); const int pj = __shfl_xor(bj, 32);
            const bool mine = (bv > pv) || (bv == pv && bj < pj);
            const float wv = mine ? bv : pv; const int wj = mine ? bj : pj;
            if (wv > -INFINITY) bmask |= 1u << wj;
            if (mine) {
#pragma unroll
                for (int r = 0; r < 16; ++r) if (crow(r, hi) == bj) gv[r] = -INFINITY;
            }
        }
    }
    return bmask;
}
__device__ __forceinline__ void gate_unit(const Frame& F, int bh, int n, const bf16* Z, const bf16* KMH, const bf16* KML, unsigned* CNT, unsigned* LIST) {
    const int b = bh >> 3, h = bh & 7, q32 = F.lane & 31, hi = F.lane >> 5;
    const int t = 256 * n + 32 * F.wave + q32;
    bf16x8 qr[8];
    { const bf16* qp = Z + ((size_t)b * SEQ + t) * ZP + ZC_QA + h * HD + 8 * hi;
#pragma unroll
      for (int s = 0; s < 8; ++s) qr[s] = *(const bf16x8*)(qp + 16 * s); }
    const unsigned bmask = moba_mask(F, bh, n, qr, KMH, KML);
    LAS unsigned* cl = (LAS unsigned*)F.lds;
    if (F.tid < 64) cl[F.tid] = 0u;
    __syncthreads();
    unsigned m = (hi == 0) ? bmask : 0u;
    int jsel[3]; unsigned posl[3];
#pragma unroll
    for (int r = 0; r < 3; ++r) {
        jsel[r] = -1; posl[r] = 0u;
        if (m != 0u) { const int jj = __ffs((int)m) - 1; m &= m - 1u; jsel[r] = jj; posl[r] = __hip_atomic_fetch_add(cl + jj, 1u, __ATOMIC_RELAXED, __HIP_MEMORY_SCOPE_WORKGROUP); }
    }
    __syncthreads();
    if (F.tid < n) { const unsigned c = cl[F.tid]; cl[32 + F.tid] = c ? atomicAdd(CNT + bh * 32 + F.tid, c) : 0u; }
    __syncthreads();
#pragma unroll
    for (int r = 0; r < 3; ++r) if (jsel[r] >= 0) LIST[((size_t)bh * 32 + jsel[r]) * 8192 + cl[32 + jsel[r]] + posl[r]] = (unsigned)t | ((unsigned)r << 13);
    __syncthreads();
}
#define G_TILE(tile_, MODE_, qpos_) do { \
        f32x16 p0 = {}, p1 = {}; \
        _Pragma("unroll") for (int s = 0; s < 8; ++s) { \
            const bf16x8 a0 = *(const LAS bf16x8*)(F.lds + G_KS + ((64 * (tile_) + q32) * GK_P + 16 * s + 8 * hi) * 2); \
            const bf16x8 a1 = *(const LAS bf16x8*)(F.lds + G_KS + ((64 * (tile_) + 32 + q32) * GK_P + 16 * s + 8 * hi) * 2); \
            p0 = MFMA32(a0, qr[s], p0); p1 = MFMA32(a1, qr[s], p1); } \
        if (MODE_) { const int kb0 = 64 * (tile_); \
            _Pragma("unroll") for (int r = 0; r < 16; ++r) { const int kp = kb0 + crow(r, hi); \
                p0[r] = (kp <= (qpos_)) ? p0[r] * C2 : NEG; p1[r] = (kp + 32 <= (qpos_)) ? p1[r] * C2 : NEG; } } \
        else { _Pragma("unroll") for (int r = 0; r < 16; ++r) { p0[r] *= C2; p1[r] *= C2; } } \
        float mt = p0[0]; \
        _Pragma("unroll") for (int r = 1; r < 16; ++r) mt = fmaxf(mt, p0[r]); \
        _Pragma("unroll") for (int r = 0; r < 16; ++r) mt = fmaxf(mt, p1[r]); \
        mt = fmaxf(mt, __shfl_xor(mt, 32)); \
        const float mn = fmaxf(mrow, mt), alpha = ex2(mrow - mn); \
        mrow = mn; \
        float ls = 0.f; \
        _Pragma("unroll") for (int r = 0; r < 16; ++r) { p0[r] = ex2(p0[r] - mn); p1[r] = ex2(p1[r] - mn); ls += p0[r] + p1[r]; } \
        lrow = lrow * alpha + ls; \
        if (__ballot(alpha != 1.f) != 0ull) { _Pragma("unroll") for (int d = 0; d < 4; ++d) O[d] *= alpha; } \
        bf16x8 pb[2][2]; \
        _Pragma("unroll") for (int s = 0; s < 2; ++s) { v4u x0, x1; \
            x0.x = cvt_pk_bf16(p0[8 * s + 0], p0[8 * s + 1]); x0.y = cvt_pk_bf16(p0[8 * s + 2], p0[8 * s + 3]); x0.z = cvt_pk_bf16(p0[8 * s + 4], p0[8 * s + 5]); x0.w = cvt_pk_bf16(p0[8 * s + 6], p0[8 * s + 7]); \
            x1.x = cvt_pk_bf16(p1[8 * s + 0], p1[8 * s + 1]); x1.y = cvt_pk_bf16(p1[8 * s + 2], p1[8 * s + 3]); x1.z = cvt_pk_bf16(p1[8 * s + 4], p1[8 * s + 5]); x1.w = cvt_pk_bf16(p1[8 * s + 6], p1[8 * s + 7]); \
            pb[0][s] = __builtin_bit_cast(bf16x8, x0); pb[1][s] = __builtin_bit_cast(bf16x8, x1); } \
        _Pragma("unroll") for (int d = 0; d < 4; ++d) \
        _Pragma("unroll") for (int sub = 0; sub < 2; ++sub) \
        _Pragma("unroll") for (int s = 0; s < 2; ++s) { \
            const LAS unsigned char* vp = F.lds + G_VS + ((32 * d + q32) * GV_P + 64 * (tile_) + 32 * sub + 16 * s + 4 * hi) * 2; \
            const v2u lo = *(const LAS v2u*)vp, hh = *(const LAS v2u*)(vp + 16); \
            v4u av; av.x = lo.x; av.y = lo.y; av.z = hh.x; av.w = hh.y; \
            O[d] = MFMA32(__builtin_bit_cast(bf16x8, av), pb[sub][s], O[d]); } \
    } while (0)
#define G_WRITE(t_, slot_, valid_) do { \
        const float lt = lrow + __shfl_xor(lrow, 32); const float inv = 1.f / lt; \
        if (valid_) { const size_t prow = ((size_t)bh * SEQ + (t_)) * 4 + (slot_); \
            bf16* pp = PO + prow * 128 + 4 * hi; \
            _Pragma("unroll") for (int d = 0; d < 4; ++d) \
            _Pragma("unroll") for (int r4 = 0; r4 < 4; ++r4) { v2u o; o.x = cvt_pk_bf16(O[d][4 * r4] * inv, O[d][4 * r4 + 1] * inv); o.y = cvt_pk_bf16(O[d][4 * r4 + 2] * inv, O[d][4 * r4 + 3] * inv); \
                *(v2u*)(pp + 32 * d + 8 * r4) = o; } \
            if (hi == 0) { f32x2 ml; ml.x = mrow; ml.y = lt; *(f32x2*)(PML + 2 * prow) = ml; } } \
    } while (0)
__device__ __forceinline__ void attn_queue(const Frame& F, const bf16* Z, const bf16* VT, const unsigned* CNT, unsigned* QCTR, const unsigned* LIST, bf16* PO, float* PML) {
    const int q32 = F.lane & 31, hi = F.lane >> 5, w = F.wave;
    constexpr float C2 = 0.08838834764831845f * 1.4426950408889634f;
    constexpr float NEG = -1e30f;
    LAS unsigned* misc = (LAS unsigned*)(F.lds + G_MISC);
    for (;;) {
        if (F.tid == 0) misc[0] = atomicAdd(QCTR, 1u);
        LDS_BARRIER();
        const int u = (int)misc[0];
        if (u >= N_UNITS) break;
        const int bh = u & 31, blk = u >> 5;
        const int b = bh >> 3, h = bh & 7;
        const size_t rowb = (size_t)b * SEQ;
        { const bf16* Kg = Z + (rowb + 256 * blk) * ZP + ZC_KA + h * HD; const bf16* Vg = VT + (size_t)(h * HD) * M + rowb + 256 * blk;
#pragma unroll 4
          for (int i = 0; i < 8; ++i) { const int idx = F.tid + 512 * i;
              const v4u kv = *(const v4u*)(Kg + (size_t)(idx >> 4) * ZP + 8 * (idx & 15));
              const v4u vv = *(const v4u*)(Vg + (size_t)(idx >> 5) * M + 8 * (idx & 31));
              *(LAS v4u*)(F.lds + G_KS + ((idx >> 4) * GK_P + 8 * (idx & 15)) * 2) = kv;
              *(LAS v4u*)(F.lds + G_VS + ((idx >> 5) * GV_P + 8 * (idx & 31)) * 2) = vv; } }
        LDS_BARRIER();
        {
            const int cntj = (int)CNT[bh * 32 + blk]; const unsigned* lst = LIST + ((size_t)bh * 32 + blk) * 8192;
            const int nch = (cntj + 31) >> 5;
#define G_ENTRY(c_) lst[(32 * (c_) + q32 < cntj) ? 32 * (c_) + q32 : 32 * (c_)]
            unsigned e_cur = 0u;
            if (w < nch) e_cur = G_ENTRY(w);
            for (int c = w; c < nch; c += NWAVES) {
                const bool valid = 32 * c + q32 < cntj;
                const int t = (int)(e_cur & 8191u), slot = (int)(e_cur >> 13);
                unsigned e_nxt = 0u; if (c + NWAVES < nch) e_nxt = G_ENTRY(c + NWAVES);
                bf16x8 qr[8];
                { const bf16* qp = Z + (rowb + t) * ZP + ZC_QA + h * HD + 8 * hi;
#pragma unroll
                  for (int s = 0; s < 8; ++s) qr[s] = *(const bf16x8*)(qp + 16 * s); }
                f32x16 O[4]; O[0] = f32x16{}; O[1] = f32x16{}; O[2] = f32x16{}; O[3] = f32x16{};
                float mrow = NEG, lrow = 0.f;
#pragma unroll 1
                for (int tile = 0; tile < 4; ++tile) G_TILE(tile, 0, 0);
                G_WRITE(t, slot, valid);
                e_cur = e_nxt;
            }
#undef G_ENTRY
        }
        {
            const int qpos = 32 * w + q32, t = 256 * blk + qpos;
            bf16x8 qr[8];
            { const bf16* qp = Z + (rowb + t) * ZP + ZC_QA + h * HD + 8 * hi;
#pragma unroll
              for (int s = 0; s < 8; ++s) qr[s] = *(const bf16x8*)(qp + 16 * s); }
            f32x16 O[4]; O[0] = f32x16{}; O[1] = f32x16{}; O[2] = f32x16{}; O[3] = f32x16{};
            float mrow = NEG, lrow = 0.f;
#pragma unroll 1
            for (int tile = 0; tile < 4; ++tile) { if (64 * tile <= 32 * w + 31) G_TILE(tile, 1, qpos); }
            G_WRITE(t, 3, true);
        }
        LDS_BARRIER();
    }
}
__device__ __forceinline__ void attn_combine(const Frame& F, const bf16* PO, const float* PML, bf16* OAB) {
    const int rsub = F.lane >> 4, c16 = F.lane & 15;
    for (int row0 = (F.bid * NWAVES + F.wave) * 8; row0 < 32 * SEQ; row0 += F.G * NWAVES * 8) {
#pragma unroll
        for (int rr = 0; rr < 2; ++rr) {
            const int row = row0 + 4 * rr + rsub;
            const int bh = row >> 13, t = row & 8191, n = t >> 8, ns = n < 3 ? n : 3;
            const f32x4* ml4 = (const f32x4*)PML + (size_t)row * 2;
            const f32x4 mA = ml4[0], mB = ml4[1];
            const float m0 = ns > 0 ? mA[0] : -1e30f, m1 = ns > 1 ? mA[2] : -1e30f, m2 = ns > 2 ? mB[0] : -1e30f, m3 = mB[2];
            const float mx = fmaxf(fmaxf(m0, m1), fmaxf(m2, m3));
            const float w0 = ns > 0 ? mA[1] * ex2(m0 - mx) : 0.f, w1 = ns > 1 ? mA[3] * ex2(m1 - mx) : 0.f, w2 = ns > 2 ? mB[1] * ex2(m2 - mx) : 0.f, w3 = mB[3] * ex2(m3 - mx);
            const float inv = 1.f / (w0 + w1 + w2 + w3);
            const v4u* po = (const v4u*)(PO + (size_t)row * 4 * 128) + c16;
            const v4u z4 = {0u, 0u, 0u, 0u};
            const v4u p3 = po[48], p0 = ns > 0 ? po[0] : z4, p1 = ns > 1 ? po[16] : z4, p2 = ns > 2 ? po[32] : z4;
            v4u o;
#define CMB(c) cvt_pk_bf16((w0 * bf_lo(p0.c) + w1 * bf_lo(p1.c) + w2 * bf_lo(p2.c) + w3 * bf_lo(p3.c)) * inv, (w0 * bf_hi(p0.c) + w1 * bf_hi(p1.c) + w2 * bf_hi(p2.c) + w3 * bf_hi(p3.c)) * inv)
            o.x = CMB(x); o.y = CMB(y); o.z = CMB(z); o.w = CMB(w);
#undef CMB
            *(v4u*)(OAB + ((size_t)(bh >> 3) * SEQ + t) * DM + (bh & 7) * HD + 8 * c16) = o;
        }
    }
}
__device__ __forceinline__ void ln1_row(int lane, const float* xrow, const bf16* mrow, const float* g, const float* bb, bf16* orow) {
    const f32x4* xr = (const f32x4*)xrow + lane; const v2u* mr = (const v2u*)mrow + lane;
    f32x4 v[8]; float s = 0.f;
#pragma unroll
    for (int j = 0; j < 8; ++j) { const f32x4 xv = xr[64 * j]; const v2u mv = mr[64 * j];
        v[j][0] = xv[0] * ALPHA + bf_lo(mv.x); v[j][1] = xv[1] * ALPHA + bf_hi(mv.x); v[j][2] = xv[2] * ALPHA + bf_lo(mv.y); v[j][3] = xv[3] * ALPHA + bf_hi(mv.y);
        s += (v[j][0] + v[j][1]) + (v[j][2] + v[j][3]); }
    const float mean = wave_sum(s) * (1.f / DM); float s2 = 0.f;
#pragma unroll
    for (int j = 0; j < 8; ++j) { const f32x4 d = v[j] - mean; s2 += (d[0] * d[0] + d[1] * d[1]) + (d[2] * d[2] + d[3] * d[3]); }
    const float rstd = 1.f / sqrtf(wave_sum(s2) * (1.f / DM) + LN_EPS);
    v2u* o8 = (v2u*)orow + lane;
#pragma unroll
    for (int j = 0; j < 8; ++j) { const f32x4 gg = ((const f32x4*)g)[64 * j + lane], b4 = ((const f32x4*)bb)[64 * j + lane];
        const f32x4 y = (v[j] - mean) * rstd * gg + b4; v2u o; o.x = cvt_pk_bf16(y[0], y[1]); o.y = cvt_pk_bf16(y[2], y[3]); o8[64 * j] = o; }
}
__device__ __forceinline__ void ln2_row(int lane, const bf16* prow, float* row, const float* g, const float* bb) {
    const v2u* pr = (const v2u*)prow + lane; f32x4* xr = (f32x4*)row + lane;
    f32x4 v[8]; float s = 0.f;
#pragma unroll
    for (int j = 0; j < 8; ++j) { const v2u pv = pr[64 * j]; v[j][0] = bf_lo(pv.x); v[j][1] = bf_hi(pv.x); v[j][2] = bf_lo(pv.y); v[j][3] = bf_hi(pv.y); s += (v[j][0] + v[j][1]) + (v[j][2] + v[j][3]); }
    const float mean = wave_sum(s) * (1.f / DM); float s2 = 0.f;
#pragma unroll
    for (int j = 0; j < 8; ++j) { const f32x4 d = v[j] - mean; s2 += (d[0] * d[0] + d[1] * d[1]) + (d[2] * d[2] + d[3] * d[3]); }
    const float rstd = 1.f / sqrtf(wave_sum(s2) * (1.f / DM) + LN_EPS);
#pragma unroll
    for (int j = 0; j < 8; ++j) { const f32x4 gg = ((const f32x4*)g)[64 * j + lane], b4 = ((const f32x4*)bb)[64 * j + lane]; xr[64 * j] = (v[j] - mean) * rstd * gg + b4; }
}

typedef unsigned gu32;
#define XB_TMO      128
#define XB_XCNT(j)  (256  + 64 * (j))
#define XB_XSUB(j)  (1280 + 64 * (j))
#define XB_XGEN(j)  (2304 + 64 * (j))
#define XB_TOP      3328
#define XB_TOPGEN   3392
#define XCD_BAR_WORDS 3456
#define XB_SPIN_CAP (1u << 18)

__device__ __forceinline__ unsigned xb_ld(unsigned* p)              { return __hip_atomic_load(p, __ATOMIC_RELAXED, __HIP_MEMORY_SCOPE_AGENT); }
__device__ __forceinline__ unsigned xb_add(unsigned* p, unsigned v) { return __hip_atomic_fetch_add(p, v, __ATOMIC_RELAXED, __HIP_MEMORY_SCOPE_AGENT); }
__device__ __forceinline__ unsigned xb_xcc_id() { return (unsigned)__builtin_amdgcn_s_getreg((3 << 11) | 20) & 0xFu; }
#define XB_SPIN(cond, bar) do { unsigned _sp = 0; while (cond) { __builtin_amdgcn_s_sleep(1); \
    if ((++_sp & 255u) == 0u) { if (xb_ld(&(bar)[XB_TMO])) break; if (_sp > XB_SPIN_CAP) { atomicAdd(&(bar)[XB_TMO], 1u); break; } } } } while (0)

struct XcdBarrier {
    unsigned* bar; unsigned x;
    volatile LAS unsigned* st;
};

__device__ __forceinline__ XcdBarrier xcd_barrier_post(unsigned* bar, volatile LAS unsigned* st) {
    XcdBarrier b; b.bar = bar; b.x = xb_xcc_id(); b.st = st;
    if (threadIdx.x == 0) (void)xb_add(&bar[XB_XCNT(b.x)], 1u);
    return b;
}
__device__ __forceinline__ void xcd_barrier_complete(unsigned* bar, unsigned x, unsigned& nloc, unsigned& nx) {
    const unsigned G = gridDim.x * gridDim.y * gridDim.z;
    unsigned sum, cnt, mine, sp = 0u;
    for (;;) {
        sum = 0u; cnt = 0u; mine = 0u;
#pragma unroll
        for (unsigned j = 0; j < 16; ++j) { const unsigned c = xb_ld(&bar[XB_XCNT(j)]); sum += c; cnt += (c > 0u) ? 1u : 0u; mine = (j == x) ? c : mine; }
        if (sum == G) break;
        __builtin_amdgcn_s_sleep(1);
        if ((++sp & 255u) == 0u) { if (xb_ld(&bar[XB_TMO])) break; if (sp > XB_SPIN_CAP) { atomicAdd(&bar[XB_TMO], 1u); break; } }
    }
    nloc = mine > 0u ? mine : 1u; nx = cnt > 0u ? cnt : 1u;
}

__device__ __forceinline__ void xcd_barrier(const XcdBarrier& b) {
    asm volatile("s_waitcnt vmcnt(0)" ::: "memory");
    __syncthreads();
    if (threadIdx.x == 0) {
        unsigned* bar = b.bar;
        __builtin_amdgcn_s_waitcnt(0);
        unsigned nloc = b.st[0], nx = b.st[1];
        if (nloc == 0u) { xcd_barrier_complete(bar, b.x, nloc, nx); b.st[0] = nloc; b.st[1] = nx; }
        const unsigned old = xb_add(&bar[XB_XSUB(b.x)], 1u);
        const unsigned gen = old / nloc;
        if (old + 1u == (gen + 1u) * nloc) {
            __builtin_amdgcn_fence(__ATOMIC_RELEASE, "agent");
            asm volatile("s_waitcnt vmcnt(0)" ::: "memory");
            const unsigned og = xb_add(&bar[XB_TOP], 1u);
            const unsigned tg = og / nx;
            if (og + 1u == (tg + 1u) * nx) xb_add(&bar[XB_TOPGEN], 1u);
            else XB_SPIN(xb_ld(&bar[XB_TOPGEN]) == tg, bar);
            __builtin_amdgcn_fence(__ATOMIC_ACQUIRE, "agent");
            xb_add(&bar[XB_XGEN(b.x)], 1u);
            asm volatile("s_waitcnt vmcnt(0)" ::: "memory");
        } else {
            XB_SPIN(xb_ld(&bar[XB_XGEN(b.x)]) == gen, bar);
            __builtin_amdgcn_fence(__ATOMIC_ACQUIRE, "agent");
            asm volatile("s_waitcnt vmcnt(0)" ::: "memory");
        }
    }
    __syncthreads();
}

struct Args { const float* in[14]; float* out; unsigned char* ws; int ph_lo, ph_hi; };
__global__ void __launch_bounds__(NTHR, 2) fwd_kernel(Args args) {
    extern __shared__ __attribute__((aligned(16))) unsigned char lds_raw[];
    Frame F; F.lds = (LAS unsigned char*)lds_raw; F.tid = threadIdx.x; F.lane = F.tid & 63; F.wave = __builtin_amdgcn_readfirstlane(F.tid >> 6); F.G = gridDim.x; F.bid = blockIdx.x;
    unsigned char* ws = args.ws;
    const int lo = args.ph_lo, hi = args.ph_hi;
#ifndef PHMASK
#define PHMASK 0x1fff
#endif
#define IN(k) ((((PHMASK) >> (k)) & 1) && lo <= (k) && (k) < hi)
    volatile LAS unsigned* bst = (volatile LAS unsigned*)(F.lds + LDS_BYTES - 64);
    if (F.tid < 2) bst[F.tid] = 0u;
    __syncthreads();
    const XcdBarrier xbar = xcd_barrier_post((unsigned*)(ws + WS_BAR), bst);
#define SEAM(k) do { if (IN(k) && IN((k) + 1)) { if (hi > NPHASE) cg::this_grid().sync();   else xcd_barrier(xbar); } } while (0)
    bf16* WIN = (bf16*)(ws + WS_WIN); bf16* WP = (bf16*)(ws + WS_WP); bf16* WO = (bf16*)(ws + WS_WO); bf16* WGU = (bf16*)(ws + WS_WGU); bf16* WD = (bf16*)(ws + WS_WD);
    bf16* XB = (bf16*)(ws + WS_XB); bf16* Zb = (bf16*)(ws + WS_Z); bf16* VT = (bf16*)(ws + WS_VT); bf16* OAB = (bf16*)(ws + WS_OAB);
    bf16* KMH = (bf16*)(ws + WS_KMH); bf16* KML = (bf16*)(ws + WS_KML); float* DC = (float*)(ws + WS_DC);
    float* ST = (float*)(ws + WS_WIN);
    unsigned* CNT = (unsigned*)(ws + WS_CNT); unsigned* LIST = (unsigned*)(ws + WS_LIST); float* PML = (float*)(ws + WS_PML);
    bf16* MIX = (bf16*)(ws + WS_PRE1); bf16* PRE2 = (bf16*)(ws + WS_PRE1);   bf16* ACT = (bf16*)(ws + WS_ACT); bf16* MERGED = (bf16*)(ws + WS_MERGED); bf16* H1N = (bf16*)(ws + WS_H1N);

    if (IN(0)) { p0_prologue(F, args.in, ws); }
    SEAM(0);
    if (IN(1)) {
        { pg8::Gemm g{XB, WIN, M, ZP, DM}; pg8::StaticOrder S; S.init(M, ZP, F.G, F.bid);
          pg8::EpiBf16<0> E{Zb, ZP, nullptr, 0, 0, 1.f};
          pg8::gemm_phase<pg8::EpiBf16<0>, pg8::StaticOrder, PG8_ALIGN, PG8_SP2>(F.lds, g, S, E); }
        { pg8::Gemm g{WIN + (size_t)ZP * DM, XB, 2048, M, DM}; pg8::StaticOrder S; S.init(2048, M, F.G, F.bid);
          pg8::EpiBf16<0> E{VT, M, nullptr, 0, 0, 1.f};
          pg8::gemm_phase<pg8::EpiBf16<0>, pg8::StaticOrder, PG8_ALIGN, PG8_SP2>(F.lds, g, S, E); }
    }
    SEAM(1);
    if (IN(2)) {
        if (F.bid == 0) for (int i = F.tid; i < 1200; i += NTHR) CNT[i] = 0u;
        for (int it = F.bid; it < 32 * 32; it += F.G) kmean_item(F, it, Zb, KMH, KML);
        for (int it = F.bid; it < 32 * 8; it += F.G) hgrn_item<false>(F, it, Zb, VT, args.in[6], ST, DC, args.in[5], OAB);
    }
    SEAM(2);
    if (IN(3)) {
        hgrn_scan(F, ST, DC);
        for (int u = F.bid; u < 32 * 31; u += F.G) gate_unit(F, u & 31, 1 + (u >> 5), Zb, KMH, KML, CNT, LIST);
    }
    SEAM(3);
    if (IN(4)) {
        for (int it = F.bid; it < 32 * 8; it += F.G) hgrn_item<true>(F, it, Zb, VT, args.in[6], ST, DC, args.in[5], OAB);
    }
    if (IN(5)) {
        attn_queue(F, Zb, VT, CNT, CNT + 1024, LIST, (bf16*)args.out, PML);
#ifdef DIAG_CMP
        { const int vcu = (F.bid & 7) * 32 + (F.bid >> 3), bh = vcu >> 3, s = vcu & 7;
          attn_unit(F, bh, s, Zb, VT, KMH, KML, OAB); attn_unit(F, bh, 15 - s, Zb, VT, KMH, KML, OAB);
          attn_unit(F, bh, 16 + s, Zb, VT, KMH, KML, OAB); attn_unit(F, bh, 31 - s, Zb, VT, KMH, KML, OAB); }
#endif
    }
    SEAM(5);
    if (IN(6)) { attn_combine(F, (const bf16*)args.out, PML, OAB); }
    SEAM(6);
    if (IN(7)) {
        pg8::Gemm g{OAB, WP, M, DM, DM}; pg8::StaticOrder S; S.init(M, DM, F.G, F.bid);
        pg8::EpiProj E{Zb, ZP, ZC_GA, ZC_GB, MERGED, DM};
        pg8::gemm_phase<pg8::EpiProj, pg8::StaticOrder, PG8_ALIGN, PG8_SP2>(F.lds, g, S, E);
    }
    SEAM(7);
    if (IN(8)) {
        pg8::Gemm g{MERGED, WO, M, DM, DM}; pg8::StaticOrder S; S.init(M, DM, F.G, F.bid);
        pg8::EpiBf16<0> E{MIX, DM, nullptr, 0, 0, 1.f};
        pg8::gemm_phase<pg8::EpiBf16<0>, pg8::StaticOrder, PG8_ALIGN, PG8_SP2>(F.lds, g, S, E);
    }
    SEAM(8);
    if (IN(9)) {
        for (int mm = F.bid * NWAVES + F.wave; mm < M; mm += F.G * NWAVES) ln1_row(F.lane, args.in[0] + (size_t)mm * DM, MIX + (size_t)mm * DM, args.in[7], args.in[8], H1N + (size_t)mm * DM);
    }
    SEAM(9);
    if (IN(10)) {
        pg8::Gemm g{H1N, WGU, M, 2 * FFH, DM}; pg8::StaticOrder S; S.init(M, 2 * FFH, F.G, F.bid);
        pg8::EpiSwiGLU E{ACT, FFH};
        pg8::gemm_phase<pg8::EpiSwiGLU, pg8::StaticOrder, PG8_ALIGN, PG8_SP2>(F.lds, g, S, E);
    }
    SEAM(10);
    if (IN(11)) {
        pg8::Gemm g{ACT, WD, M, DM, FFH}; pg8::StaticOrder S; S.init(M, DM, F.G, F.bid);
        pg8::EpiPre2 E{H1N, PRE2, DM, ALPHA};
        pg8::gemm_phase<pg8::EpiPre2, pg8::StaticOrder, PG8_ALIGN, PG8_SP2>(F.lds, g, S, E);
    }
    SEAM(11);
    if (IN(12)) {
        for (int mm = F.bid * NWAVES + F.wave; mm < M; mm += F.G * NWAVES) ln2_row(F.lane, PRE2 + (size_t)mm * DM, args.out + (size_t)mm * DM, args.in[12], args.in[13]);
    }
#undef IN
#undef SEAM
}

extern "C" void kernel_launch(void* const* d_in, const int* in_sizes, int n_in, void* d_out, int out_size, void* d_ws, size_t ws_size, hipStream_t stream) {
    static int grid = 0;
    if (grid == 0) {
        if (n_in != 14 || in_sizes[0] != M * DM || out_size != M * DM || ws_size < WS_END) { fprintf(stderr, "kernel_launch: unexpected shapes (n_in %d, in0 %d, out %d, ws %zu)\n", n_in, n_in > 0 ? in_sizes[0] : -1, out_size, ws_size); grid = -1; return; }
        int dev = 0, cus = 0, per_cu = 0;
        if (hipGetDevice(&dev) != hipSuccess || hipDeviceGetAttribute(&cus, hipDeviceAttributeMultiprocessorCount, dev) != hipSuccess) { grid = -1; return; }
        if (hipFuncSetAttribute((const void*)fwd_kernel, hipFuncAttributeMaxDynamicSharedMemorySize, LDS_BYTES) != hipSuccess) { fprintf(stderr, "kernel_launch: hipFuncSetAttribute failed\n"); grid = -1; return; }
        if (hipOccupancyMaxActiveBlocksPerMultiprocessor(&per_cu, (const void*)fwd_kernel, NTHR, LDS_BYTES) != hipSuccess || per_cu < 1) per_cu = 1;
        (void)hipGetLastError();
        grid = cus * per_cu;
    }
    if (grid < 0) return;
    if (hipMemsetAsync((char*)d_ws + WS_BAR, 0, 16384, stream) != hipSuccess) { fprintf(stderr, "kernel_launch: memset of the barrier words failed\n"); return; }
    Args a{};
    for (int i = 0; i < 14; ++i) a.in[i] = (const float*)d_in[i];
    a.out = (float*)d_out; a.ws = (unsigned char*)d_ws;
#if MK_N_LAUNCHES == 1
    a.ph_lo = 0; a.ph_hi = NPHASE;
    void* kargs[] = {&a};
    hipError_t e = hipLaunchCooperativeKernel((const void*)fwd_kernel, dim3(grid), dim3(NTHR), kargs, LDS_BYTES, stream);
    if (e != hipSuccess) fprintf(stderr, "cooperative launch failed: %s (grid %d)\n", hipGetErrorString(e), grid);
#else
    for (int p = 0; p < NPHASE; ++p) { a.ph_lo = p; a.ph_hi = p + 1; hipLaunchKernelGGL(fwd_kernel, dim3(grid), dim3(NTHR), LDS_BYTES, stream, a); }
#endif
}
```

```cpp
#include <hip/hip_runtime.h>
#include <hip/hip_cooperative_groups.h>
#include <cstdio>
#include <cstdint>
namespace cg = cooperative_groups;
namespace pg8 {
#define PG8_LAS __attribute__((address_space(3)))
typedef unsigned short bf16_t;
typedef short bf16x8 __attribute__((ext_vector_type(8)));
typedef float f32x4 __attribute__((ext_vector_type(4)));
typedef unsigned u32x4 __attribute__((ext_vector_type(4)));
constexpr int BM = 256, BK = 64, HALF = 128, HTB = HALF * BK * 2  , STAGE_BYTES = 8 * HTB, NXCD = 8, WGM = 8;

__host__ __device__ __forceinline__ int lds_byte(int r, int c) { const int st = (r >> 4) * 2 + (c >> 5), rr = r & 15, cc = c & 31, ob = rr * 64 + cc * 2; return st * 1024 + (ob ^ (((ob >> 9) & 1) << 5)); }
__host__ __device__ __forceinline__ void stage_rc(int b, int& R, int& C) { const int st = b / 1024, sb = b % 1024, swz = sb ^ (((sb >> 9) & 1) << 5); R = (st >> 1) * 16 + swz / 64; C = (st & 1) * 32 + (swz % 64) / 2; }
__host__ __device__ __forceinline__ int perm32(int rho) { const int n = rho >> 4, i = rho & 15; return 8 * (i >> 2) + 4 * n + (i & 3); }

struct Unit { int pm, pn; };
struct Gemm { const bf16_t* A; const bf16_t* Bt; int M, N, K; };

struct StaticOrder {
    int nM, nN, nwg, G, c;
    __host__ __device__ void init(int M, int N, int G_, int c_) { nM = M / BM; nN = N / BM; nwg = nM * nN; G = G_; c = c_; }
    __host__ __device__ bool next(int i, Unit& u) const {
        const long L = (long)i * G + c; if (L >= nwg) return false;
        int wgid = (int)L; { const int q = nwg / NXCD, r = nwg % NXCD, xcd = wgid % NXCD, off = wgid / NXCD; wgid = (xcd < r ? xcd * (q + 1) : r * (q + 1) + (xcd - r) * q) + off; }
        const int nig = WGM * nN, gid = wgid / nig, fm = gid * WGM, gsz = (nM - fm) < WGM ? (nM - fm) : WGM;
        u.pm = fm + ((wgid % nig) % gsz); u.pn = (wgid % nig) / gsz; return true;
    }
    __device__ __forceinline__ void a_ready(const Unit&) const {}
    __device__ __forceinline__ void done(const Unit&) const {}
};

typedef float f32x2c __attribute__((ext_vector_type(2))); typedef __bf16 bf16x2c __attribute__((ext_vector_type(2)));
__device__ __forceinline__ unsigned cvt_pk_bf16(float lo, float hi) { f32x2c v = {lo, hi}; bf16x2c b = __builtin_convertvector(v, bf16x2c); return __builtin_bit_cast(unsigned, b); }
typedef float f32x2 __attribute__((ext_vector_type(2)));
__device__ __forceinline__ f32x2 gelu_pk(f32x2 v) {
    const f32x2 av = __builtin_elementwise_abs(v), d = av * 0.2316418882f + 1.0f;
    f32x2 t; t.x = __builtin_amdgcn_rcpf(d.x); t.y = __builtin_amdgcn_rcpf(d.y);
    f32x2 q = t * 0.5307027145f + (-0.7265760135f); q = q * t + 0.7107068705f; q = q * t + (-0.142248368f); q = q * t + 0.127414796f; q = q * t;
    const f32x2 s = (v * v) * (-0.72134752044f);
    f32x2 e; e.x = __builtin_amdgcn_exp2f(s.x); e.y = __builtin_amdgcn_exp2f(s.y);
    const f32x2 m = v * (q * e), r = v - m;
    f32x2 o; o.x = v.x < 0.f ? m.x : r.x; o.y = v.y < 0.f ? m.y : r.y; return o;
}

template <int ACT  > struct EpiBf16 {
    static constexpr bool PERM = true, AFTER_DRAIN = false, HAS_MID = false; static_assert(ACT == 0 || ACT == 1, "EpiBf16: ACT is 0 (none) or 1 (gelu_pk)");
    bf16_t* O; int ldc; const float* bias; int split_cols; size_t split_stride; float scale0;
    __device__ __forceinline__ void operator()(const f32x4 (&acc)[2][2][4][2], const Unit& u, int wr, int wc, int fr, int fq) const {
        const int row0 = u.pm * BM + wr * 64 + fr; int colt = u.pn * BM; bf16_t* base = O;
        float sc = 1.f; if (split_cols) { const int t = colt / split_cols; base += (size_t)t * split_stride; colt -= t * split_cols; if (t == 0) sc = scale0; }
        const int col0 = colt + wc * 32 + 8 * fq, bcol0 = u.pn * BM + wc * 32 + 8 * fq;
        f32x4 bv[2][2];
#pragma unroll
        for (int bj = 0; bj < 2; ++bj)
#pragma unroll
            for (int n = 0; n < 2; ++n) bv[bj][n] = bias ? *(const f32x4*)(bias + bcol0 + bj * HALF + 4 * n) : (f32x4){0.f, 0.f, 0.f, 0.f};
#pragma unroll
        for (int ai = 0; ai < 2; ++ai)
#pragma unroll
            for (int m = 0; m < 4; ++m) { bf16_t* rowp = base + (size_t)(row0 + ai * HALF + m * 16) * ldc + col0;
#pragma unroll
                for (int bj = 0; bj < 2; ++bj) { f32x4 v0 = acc[ai][bj][m][0] + bv[bj][0], v1 = acc[ai][bj][m][1] + bv[bj][1];
                    if (ACT == 1) { f32x2 a = gelu_pk((f32x2){v0[0], v0[1]}), b = gelu_pk((f32x2){v0[2], v0[3]}), c = gelu_pk((f32x2){v1[0], v1[1]}), d = gelu_pk((f32x2){v1[2], v1[3]});
                        v0 = (f32x4){a.x, a.y, b.x, b.y}; v1 = (f32x4){c.x, c.y, d.x, d.y}; }
                    v0 = v0 * sc; v1 = v1 * sc; u32x4 w; w.x = cvt_pk_bf16(v0[0], v0[1]); w.y = cvt_pk_bf16(v0[2], v0[3]); w.z = cvt_pk_bf16(v1[0], v1[1]); w.w = cvt_pk_bf16(v1[2], v1[3]);
                    *(u32x4*)(rowp + bj * HALF) = w; } }
    }
};
__device__ __forceinline__ float bf_lo(unsigned w) { return __uint_as_float(w << 16); }
__device__ __forceinline__ float bf_hi(unsigned w) { return __uint_as_float(w & 0xffff0000u); }
__device__ __forceinline__ float sigm(float x) { return __builtin_amdgcn_rcpf(1.f + __builtin_amdgcn_exp2f(-1.4426950408889634f * x)); }
__device__ __forceinline__ float enx(float x) { return __builtin_amdgcn_exp2f(-1.4426950408889634f * x); }

struct EpiSwiGLU {
    static constexpr bool PERM = true, AFTER_DRAIN = false, HAS_MID = false;
    bf16_t* O; int ldc;
    __device__ __forceinline__ void operator()(const f32x4 (&acc)[2][2][4][2], const Unit& u, int wr, int wc, int fr, int fq) const {
        const int row0 = u.pm * BM + wr * 64 + fr, col0 = u.pn * HALF + wc * 32 + 8 * fq;
#pragma unroll
        for (int ai = 0; ai < 2; ++ai)
#pragma unroll
            for (int m = 0; m < 4; ++m) {
                bf16_t* p = O + (size_t)(row0 + ai * HALF + m * 16) * ldc + col0;
                const f32x4 g0 = acc[ai][0][m][0], g1 = acc[ai][0][m][1], u0 = acc[ai][1][m][0], u1 = acc[ai][1][m][1];
                u32x4 w;
                w.x = cvt_pk_bf16(g0[0] * sigm(g0[0]) * u0[0], g0[1] * sigm(g0[1]) * u0[1]);
                w.y = cvt_pk_bf16(g0[2] * sigm(g0[2]) * u0[2], g0[3] * sigm(g0[3]) * u0[3]);
                w.z = cvt_pk_bf16(g1[0] * sigm(g1[0]) * u1[0], g1[1] * sigm(g1[1]) * u1[1]);
                w.w = cvt_pk_bf16(g1[2] * sigm(g1[2]) * u1[2], g1[3] * sigm(g1[3]) * u1[3]);
                *(u32x4*)p = w;
            }
    }
};
struct EpiProj {
    static constexpr bool PERM = true, AFTER_DRAIN = false, HAS_MID = true;
    const bf16_t* Z; int ldz, ga_off, gb_off; bf16_t* O; int ldc;
    __device__ __forceinline__ void mid(f32x4 (&acc)[2][2][4][2], const Unit& u, int wr, int wc, int fr, int fq) const {
        int row0 = u.pm * BM + wr * 64 + fr, col0 = u.pn * BM + wc * 32 + 8 * fq;
        asm volatile("" : "+v"(row0), "+v"(col0));
#pragma unroll
        for (int ai = 0; ai < 2; ++ai)
#pragma unroll
            for (int mp = 0; mp < 2; ++mp) {
                u32x4 ga[2][2], gb[2][2];
#pragma unroll
                for (int mm = 0; mm < 2; ++mm) { const bf16_t* zr = Z + (size_t)(row0 + ai * HALF + (2 * mp + mm) * 16) * ldz + col0;
#pragma unroll
                    for (int bj = 0; bj < 2; ++bj) { ga[mm][bj] = *(const u32x4*)(zr + ga_off + bj * HALF); gb[mm][bj] = *(const u32x4*)(zr + gb_off + bj * HALF); } }
#pragma unroll
                for (int mm = 0; mm < 2; ++mm)
#pragma unroll
                    for (int bj = 0; bj < 2; ++bj) { const int m = 2 * mp + mm; const u32x4 a = ga[mm][bj], b = gb[mm][bj];
#define PJ_R(aw, bw, LO) ((1.f + enx(LO ? bf_lo(bw) : bf_hi(bw))) * __builtin_amdgcn_rcpf(1.f + enx(LO ? bf_lo(aw) : bf_hi(aw))))
                        f32x4 r0, r1;
                        r0[0] = PJ_R(a.x, b.x, 1); r0[1] = PJ_R(a.x, b.x, 0); r0[2] = PJ_R(a.y, b.y, 1); r0[3] = PJ_R(a.y, b.y, 0);
                        r1[0] = PJ_R(a.z, b.z, 1); r1[1] = PJ_R(a.z, b.z, 0); r1[2] = PJ_R(a.w, b.w, 1); r1[3] = PJ_R(a.w, b.w, 0);
#undef PJ_R
                        acc[ai][bj][m][0] *= r0; acc[ai][bj][m][1] *= r1; }
                asm volatile("" : "+v"(acc[ai][0][2 * mp][0]), "+v"(acc[ai][1][2 * mp + 1][1]) :: "memory");
            }
    }
    __device__ __forceinline__ void operator()(const f32x4 (&acc)[2][2][4][2], const Unit& u, int wr, int wc, int fr, int fq) const {
        const int row0 = u.pm * BM + wr * 64 + fr, col0 = u.pn * BM + wc * 32 + 8 * fq;
#pragma unroll
        for (int ai = 0; ai < 2; ++ai)
#pragma unroll
            for (int m = 0; m < 4; ++m) {
                const size_t r = (size_t)(row0 + ai * HALF + m * 16);
                const bf16_t* zr = Z + r * ldz + col0 + gb_off; bf16_t* op = O + r * ldc + col0;
#pragma unroll
                for (int bj = 0; bj < 2; ++bj) {
                    const u32x4 b = *(const u32x4*)(zr + bj * HALF);
                    const f32x4 v0 = acc[ai][bj][m][0], v1 = acc[ai][bj][m][1];
                    u32x4 w;
                    w.x = cvt_pk_bf16(v0[0] * sigm(bf_lo(b.x)), v0[1] * sigm(bf_hi(b.x)));
                    w.y = cvt_pk_bf16(v0[2] * sigm(bf_lo(b.y)), v0[3] * sigm(bf_hi(b.y)));
                    w.z = cvt_pk_bf16(v1[0] * sigm(bf_lo(b.z)), v1[1] * sigm(bf_hi(b.z)));
                    w.w = cvt_pk_bf16(v1[2] * sigm(bf_lo(b.w)), v1[3] * sigm(bf_hi(b.w)));
                    *(u32x4*)(op + bj * HALF) = w;
                }
            }
    }
};
struct EpiPre1 {
    static constexpr bool PERM = false, AFTER_DRAIN = false, HAS_MID = false;
    const float* X; float* P; int ldc; float alpha;
    __device__ __forceinline__ void operator()(const f32x4 (&acc)[2][2][4][2], const Unit& u, int wr, int wc, int fr, int fq) const {
        const int row0 = u.pm * BM + wr * 64 + fr, col0 = u.pn * BM + wc * 32 + 4 * fq;
#pragma unroll
        for (int ai = 0; ai < 2; ++ai)
#pragma unroll
            for (int m = 0; m < 4; ++m) {
                const size_t off = (size_t)(row0 + ai * HALF + m * 16) * ldc + col0;
#pragma unroll
                for (int bj = 0; bj < 2; ++bj)
#pragma unroll
                    for (int n = 0; n < 2; ++n) { const f32x4 xv = *(const f32x4*)(X + off + bj * HALF + n * 16); *(f32x4*)(P + off + bj * HALF + n * 16) = xv * alpha + acc[ai][bj][m][n]; }
            }
    }
};
struct EpiPre2 {
    static constexpr bool PERM = true, AFTER_DRAIN = false, HAS_MID = false;
    const bf16_t* H; bf16_t* O; int ldc; float alpha;
    __device__ __forceinline__ void operator()(const f32x4 (&acc)[2][2][4][2], const Unit& u, int wr, int wc, int fr, int fq) const {
        const int row0 = u.pm * BM + wr * 64 + fr, col0 = u.pn * BM + wc * 32 + 8 * fq;
#pragma unroll
        for (int ai = 0; ai < 2; ++ai)
#pragma unroll
            for (int m = 0; m < 4; ++m) {
                const size_t off = (size_t)(row0 + ai * HALF + m * 16) * ldc + col0;
#pragma unroll
                for (int bj = 0; bj < 2; ++bj) { const u32x4 hv = *(const u32x4*)(H + off + bj * HALF);
                    f32x4 h0, h1; h0[0] = bf_lo(hv.x); h0[1] = bf_hi(hv.x); h0[2] = bf_lo(hv.y); h0[3] = bf_hi(hv.y); h1[0] = bf_lo(hv.z); h1[1] = bf_hi(hv.z); h1[2] = bf_lo(hv.w); h1[3] = bf_hi(hv.w);
                    const f32x4 r0 = h0 * alpha + acc[ai][bj][m][0], r1 = h1 * alpha + acc[ai][bj][m][1];
                    u32x4 w; w.x = cvt_pk_bf16(r0[0], r0[1]); w.y = cvt_pk_bf16(r0[2], r0[3]); w.z = cvt_pk_bf16(r1[0], r1[1]); w.w = cvt_pk_bf16(r1[2], r1[3]);
                    *(u32x4*)(O + off + bj * HALF) = w; }
            }
    }
};

template <class Epi, class Sched, bool ALIGN_EPI = false, bool SP2 = false>
__device__ __forceinline__ void gemm_phase(PG8_LAS unsigned char* lds, const Gemm g, const Sched& S, const Epi& E) {
    const int tid = threadIdx.x, wid = __builtin_amdgcn_readfirstlane(tid >> 6), lane = tid & 63, wr = wid >> 2, wc = wid & 3, fr = lane & 15, fq = lane >> 4;
    const int K = g.K, nt = K / BK;
    unsigned voffA[2], voffB[2];
#pragma unroll
    for (int i = 0; i < 2; ++i) { int R, C; stage_rc(tid * 16 + i * 8192, R, C); const int Rb = Epi::PERM ? ((R & ~31) + perm32(R & 31)) : R;
        voffA[i] = (unsigned)(R * K + C) * 2u; voffB[i] = (unsigned)(Rb * K + C) * 2u; }
    const size_t kstep = (size_t)(BK * 2);
    const size_t hstep = (size_t)HALF * K * 2;
    const size_t tstep = 2 * hstep;
    const unsigned ldsw = (unsigned)wid * 1024u;
    const int aoff = lds_byte(wr * 64 + fr, fq * 8), boff = lds_byte(wc * 32 + fr, fq * 8);
#define PG8_SA(b, h) (((b) * 2 + (h)) * HTB)
#define PG8_SB(b, h) ((4 + (b) * 2 + (h)) * HTB)
#define PG8_STAGE(bufoff, gbase, voff) do { _Pragma("unroll") for (int _i = 0; _i < 2; ++_i) \
        __builtin_amdgcn_global_load_lds((const unsigned*)((const char*)(gbase) + (voff)[_i]), (PG8_LAS unsigned*)(lds + (bufoff) + ldsw + _i * 8192), 16, 0, 0); } while (0)
#define PG8_LDA(dst, b, h) do { _Pragma("unroll") for (int m = 0; m < 4; ++m) _Pragma("unroll") for (int k = 0; k < 2; ++k) dst[m][k] = *(const PG8_LAS bf16x8*)(lds + PG8_SA(b, h) + aoff + m * 2048 + k * 1024); } while (0)
#define PG8_LDB(dst, b, h) do { _Pragma("unroll") for (int n = 0; n < 2; ++n) _Pragma("unroll") for (int k = 0; k < 2; ++k) dst[n][k] = *(const PG8_LAS bf16x8*)(lds + PG8_SB(b, h) + boff + n * 2048 + k * 1024); } while (0)
#define PG8_MMA(ai, bj, At, Bt) do { __builtin_amdgcn_s_setprio(1); _Pragma("unroll") for (int m = 0; m < 4; ++m) _Pragma("unroll") for (int n = 0; n < 2; ++n) _Pragma("unroll") for (int k = 0; k < 2; ++k) \
        acc[ai][bj][m][n] = __builtin_amdgcn_mfma_f32_16x16x32_bf16(Bt[n][k], At[m][k], acc[ai][bj][m][n], 0, 0, 0); __builtin_amdgcn_s_setprio(0); } while (0)
#define PG8_WAIT_V(n) asm volatile("s_waitcnt vmcnt(" #n ")" ::: "memory")
#define PG8_WAIT_L(n) asm volatile("s_waitcnt lgkmcnt(" #n ")" ::: "memory")
#define PG8_BAR __builtin_amdgcn_s_barrier()
#define PG8_SCHED __builtin_amdgcn_sched_barrier(0)
    Unit cur, nxt; int ui = 0;
    if (!S.next(0, cur)) return;
    f32x4 acc[2][2][4][2];
#pragma unroll
    for (int a = 0; a < 2; ++a)
#pragma unroll
        for (int b = 0; b < 2; ++b)
#pragma unroll
            for (int m = 0; m < 4; ++m)
#pragma unroll
                for (int n = 0; n < 2; ++n) acc[a][b][m][n] = (f32x4){0.f, 0.f, 0.f, 0.f};
    bf16x8 At[4][2], B0[2][2], B1[2][2];
    const char* cA = (const char*)g.A + (size_t)cur.pm * tstep; const char* cB = (const char*)g.Bt + (size_t)cur.pn * tstep;
    S.a_ready(cur);
    if constexpr (SP2) {
        PG8_STAGE(PG8_SB(0, 0), cB, voffB); PG8_STAGE(PG8_SB(0, 1), cB + hstep, voffB); PG8_STAGE(PG8_SA(0, 0), cA, voffA); PG8_STAGE(PG8_SA(0, 1), cA + hstep, voffA);
        if (wr == 1) PG8_BAR;
        PG8_WAIT_V(2); PG8_BAR;
        PG8_STAGE(PG8_SB(1, 0), cB + kstep, voffB); PG8_STAGE(PG8_SA(1, 0), cA + kstep, voffA); PG8_STAGE(PG8_SB(1, 1), cB + hstep + kstep, voffB);
        PG8_WAIT_V(6); PG8_BAR;
    } else {
        PG8_STAGE(PG8_SB(0, 0), cB, voffB); PG8_STAGE(PG8_SA(0, 0), cA, voffA); PG8_STAGE(PG8_SB(0, 1), cB + hstep, voffB); PG8_STAGE(PG8_SA(0, 1), cA + hstep, voffA);
        if (wr == 1) PG8_BAR;
        PG8_WAIT_V(4); PG8_BAR;
        PG8_STAGE(PG8_SB(1, 0), cB + kstep, voffB); PG8_STAGE(PG8_SA(1, 0), cA + kstep, voffA); PG8_STAGE(PG8_SB(1, 1), cB + hstep + kstep, voffB);
        PG8_WAIT_V(6); PG8_BAR;
    }
    for (;;) {
        const bool has_next = S.next(ui + 1, nxt);
        const char* nA = has_next ? (const char*)g.A + (size_t)nxt.pm * tstep : cA; const char* nB = has_next ? (const char*)g.Bt + (size_t)nxt.pn * tstep : cB;
        for (int t = 0; t < nt; t += 2) {
            const bool last = (t == nt - 2);
            if constexpr (Epi::HAS_MID) { if (t == (nt >> 1)) E.mid(acc, cur, wr, wc, fr, fq); }
            const char* a1 = cA + (size_t)(t + 1) * kstep;
            const char* a2 = last ? nA : cA + (size_t)(t + 2) * kstep; const char* b2 = last ? nB : cB + (size_t)(t + 2) * kstep;
            const char* a3 = a2 + kstep; const char* b3 = b2 + kstep;
            if (last && has_next) S.a_ready(nxt);
            if constexpr (SP2) {
            PG8_LDB(B0, 0, 0); PG8_LDB(B1, 0, 1); PG8_SCHED; PG8_LDA(At, 0, 0); PG8_STAGE(PG8_SA(1, 1), a1 + hstep, voffA);
            PG8_WAIT_V(8); PG8_WAIT_L(0); PG8_BAR; PG8_MMA(0, 0, At, B0); PG8_MMA(0, 1, At, B1); PG8_BAR; PG8_SCHED;
            PG8_LDA(At, 0, 1); PG8_STAGE(PG8_SB(0, 0), b2, voffB); PG8_STAGE(PG8_SB(0, 1), b2 + hstep, voffB); PG8_STAGE(PG8_SA(0, 0), a2, voffA);
            PG8_WAIT_V(8); PG8_WAIT_L(0); PG8_BAR; PG8_MMA(1, 0, At, B0); PG8_MMA(1, 1, At, B1); PG8_BAR; PG8_SCHED;
            PG8_LDB(B0, 1, 0); PG8_LDB(B1, 1, 1); PG8_SCHED; PG8_LDA(At, 1, 0); PG8_STAGE(PG8_SA(0, 1), a2 + hstep, voffA);
            PG8_WAIT_V(8); PG8_WAIT_L(0); PG8_BAR; PG8_MMA(0, 0, At, B0); PG8_MMA(0, 1, At, B1); PG8_BAR; PG8_SCHED;
            PG8_LDA(At, 1, 1); PG8_STAGE(PG8_SB(1, 0), b3, voffB); PG8_STAGE(PG8_SB(1, 1), b3 + hstep, voffB); PG8_STAGE(PG8_SA(1, 0), a3, voffA);
            PG8_WAIT_V(8); PG8_WAIT_L(0); PG8_BAR; PG8_MMA(1, 0, At, B0); PG8_MMA(1, 1, At, B1); PG8_BAR; PG8_SCHED;
            } else {
            PG8_LDB(B0, 0, 0); PG8_SCHED; PG8_LDA(At, 0, 0); PG8_STAGE(PG8_SA(1, 1), a1 + hstep, voffA);
            PG8_WAIT_L(8); PG8_BAR; PG8_WAIT_L(0); PG8_MMA(0, 0, At, B0); PG8_BAR; PG8_SCHED;
            PG8_LDB(B1, 0, 1); PG8_STAGE(PG8_SB(0, 0), b2, voffB);
            PG8_BAR; PG8_WAIT_L(0); PG8_MMA(0, 1, At, B1); PG8_BAR;
            PG8_LDA(At, 0, 1); PG8_STAGE(PG8_SA(0, 0), a2, voffA);
            PG8_BAR; PG8_WAIT_L(0); PG8_MMA(1, 0, At, B0); PG8_BAR; PG8_SCHED;
            PG8_STAGE(PG8_SB(0, 1), b2 + hstep, voffB);
            PG8_WAIT_V(6); PG8_BAR; PG8_MMA(1, 1, At, B1); PG8_BAR;
            PG8_LDB(B0, 1, 0); PG8_SCHED; PG8_LDA(At, 1, 0); PG8_STAGE(PG8_SA(0, 1), a2 + hstep, voffA);
            PG8_WAIT_L(8); PG8_BAR; PG8_WAIT_L(0); PG8_MMA(0, 0, At, B0); PG8_BAR; PG8_SCHED;
            PG8_LDB(B1, 1, 1); PG8_STAGE(PG8_SB(1, 0), b3, voffB);
            PG8_BAR; PG8_WAIT_L(0); PG8_MMA(0, 1, At, B1); PG8_BAR;
            PG8_LDA(At, 1, 1); PG8_STAGE(PG8_SA(1, 0), a3, voffA);
            PG8_BAR; PG8_WAIT_L(0); PG8_MMA(1, 0, At, B0); PG8_BAR; PG8_SCHED;
            PG8_STAGE(PG8_SB(1, 1), b3 + hstep, voffB);
            PG8_WAIT_V(6); PG8_BAR; PG8_MMA(1, 1, At, B1); PG8_BAR;
            }
        }
        if constexpr (ALIGN_EPI) { if (wr == 0) PG8_BAR; }
        if constexpr (!Epi::AFTER_DRAIN) { E(acc, cur, wr, wc, fr, fq); S.done(cur); }
        if (!has_next) break;
#pragma unroll
        for (int a = 0; a < 2; ++a)
#pragma unroll
            for (int b = 0; b < 2; ++b)
#pragma unroll
                for (int m = 0; m < 4; ++m)
#pragma unroll
                    for (int n = 0; n < 2; ++n) acc[a][b][m][n] = (f32x4){0.f, 0.f, 0.f, 0.f};
        cur = nxt; cA = nA; cB = nB; ++ui;
        if constexpr (ALIGN_EPI) { if (wr == 1) PG8_BAR; }
    }
    PG8_WAIT_V(0);
    if constexpr (!ALIGN_EPI) { if (wr == 0) PG8_BAR; }
    PG8_BAR;
    if constexpr (Epi::AFTER_DRAIN) { E.fused(acc, cur, wr, wc, fr, fq, lds, wid, lane); S.done(cur); }
#undef PG8_SA
#undef PG8_SB
#undef PG8_STAGE
#undef PG8_LDA
#undef PG8_LDB
#undef PG8_MMA
#undef PG8_WAIT_V
#undef PG8_WAIT_L
#undef PG8_BAR
#undef PG8_SCHED
}
}
#ifndef PG8_SP2
#define PG8_SP2 true
#endif
#ifndef PG8_ALIGN
#define PG8_ALIGN true
#endif
#ifndef MK_N_LAUNCHES
#define MK_N_LAUNCHES 1
#endif
constexpr int NWAVES = 8, NTHR = 512;
constexpr int BATCH = 4, SEQ = 8192, DM = 2048, M = BATCH * SEQ, NH = 8, HD = 128;
constexpr int FFH = 5632, INW = 11264, ZP = 9216, NBLK = 32, MB = 256;
constexpr int ZC_QA = 0, ZC_KA = 1024, ZC_QB = 2048, ZC_FB = 3072, ZC_OG = 4096, ZC_GA = 5120, ZC_GB = 7168;
constexpr float LN_EPS = 1e-5f, RMS_EPS = 1e-6f, ALPHA = 1.189207115002721f;
constexpr int NPHASE = 13;
constexpr size_t MiB = 1u << 20;
constexpr size_t WS_WIN = 1 * MiB, WS_WP = 45 * MiB, WS_WO = 53 * MiB, WS_WGU = 61 * MiB, WS_WD = 105 * MiB;
constexpr size_t WS_XB = 128 * MiB;
constexpr size_t WS_Z = 256 * MiB;
constexpr size_t WS_VT = 832 * MiB;
constexpr size_t WS_KMH = 960 * MiB, WS_KML = 961 * MiB, WS_DC = 962 * MiB, WS_STATS = 965 * MiB, WS_CNT = 966 * MiB, WS_BAR = 967 * MiB, WS_LIST = 968 * MiB, WS_PML = 1000 * MiB, WS_END = 1008 * MiB;
constexpr size_t WS_PRE1 = WS_Z, WS_ACT = WS_Z + 256 * MiB, WS_MERGED = WS_VT, WS_OAB = WS_XB, WS_H1N = WS_XB;
constexpr int LDS_BYTES = 147456;

#define LAS __attribute__((address_space(3)))
typedef unsigned short bf16;
typedef unsigned v4u __attribute__((ext_vector_type(4)));
typedef unsigned v2u __attribute__((ext_vector_type(2)));
typedef float f32x4 __attribute__((ext_vector_type(4)));
typedef float f32x2 __attribute__((ext_vector_type(2)));
typedef float f32x16 __attribute__((ext_vector_type(16)));
typedef short bf16x8 __attribute__((ext_vector_type(8)));
typedef short s16x4 __attribute__((ext_vector_type(4)));
#define LDS_WAIT() asm volatile("s_waitcnt lgkmcnt(0)" ::: "memory")
using pg8::cvt_pk_bf16; using pg8::bf_lo; using pg8::bf_hi; using pg8::sigm;
__device__ __forceinline__ float bf2f(bf16 b) { return __uint_as_float((unsigned)b << 16); }
__device__ __forceinline__ float ex2(float x) { return __builtin_amdgcn_exp2f(x); }
__device__ __forceinline__ float lg2(float x) { return __builtin_amdgcn_logf(x); }
__device__ __forceinline__ int crow(int r, int hi) { return (r & 3) + 8 * (r >> 2) + 4 * hi; }
__device__ __forceinline__ float wave_sum(float v) {
#pragma unroll
    for (int o = 1; o < 64; o <<= 1) v += __shfl_xor(v, o);
    return v;
}

struct Frame { LAS unsigned char* lds; int tid, lane, wave, G, bid; };

__device__ __forceinline__ void transpose_item(const float* W, int N, bf16* WT, size_t dpitch, int dst_row0, int dst_k0, int k0, int n0, LAS float* scr, int lane) {
#pragma unroll 8
    for (int i = 0; i < 32; ++i) { const int kk = 2 * i + (lane >> 5); scr[kk * 33 + (lane & 31)] = W[(size_t)(k0 + kk) * N + n0 + (lane & 31)]; }
    LDS_WAIT(); asm volatile("" ::: "memory");
    const int c = lane & 7;
#pragma unroll
    for (int j = 0; j < 4; ++j) { const int n = (lane >> 3) + 8 * j; const LAS float* s = scr + (8 * c) * 33 + n;
        v4u o; o.x = cvt_pk_bf16(s[0 * 33], s[1 * 33]); o.y = cvt_pk_bf16(s[2 * 33], s[3 * 33]); o.z = cvt_pk_bf16(s[4 * 33], s[5 * 33]); o.w = cvt_pk_bf16(s[6 * 33], s[7 * 33]);
        *(v4u*)(WT + (size_t)(dst_row0 + n) * dpitch + dst_k0 + k0 + 8 * c) = o; }
    LDS_WAIT(); asm volatile("" ::: "memory");
}
__device__ __forceinline__ int win_dst_row(int n) {
    if (n < 2048) return n;
    if (n < 3072) return 9216 + (n - 2048);
    if (n < 5120) return n - 1024;
    if (n < 6144) return 9216 + 1024 + (n - 5120);
    return n - 2048;
}
__device__ __forceinline__ void p0_prologue(const Frame& F, const float* const* in, unsigned char* ws) {
    LAS float* scr = (LAS float*)(F.lds + F.wave * 16384);
    const int gw = F.bid * NWAVES + F.wave, NGW = F.G * NWAVES;
    constexpr int I_IN = 32 * 352, I_P = 16 * 64, I_WO = 32 * 64, I_G = 32 * 176, I_D = 88 * 64;
    constexpr int NITEMS = I_IN + 2 * I_P + I_WO + 2 * I_G + I_D;
    bf16* WIN = (bf16*)(ws + WS_WIN); bf16* WP = (bf16*)(ws + WS_WP); bf16* WO = (bf16*)(ws + WS_WO); bf16* WGU = (bf16*)(ws + WS_WGU); bf16* WD = (bf16*)(ws + WS_WD);
    for (int it = gw; it < NITEMS; it += NGW) {
        int r = it;
        if (r < I_IN) { const int kb = r / 352, nb = r % 352; transpose_item(in[1], INW, WIN, 2048, win_dst_row(32 * nb), 0, 64 * kb, 32 * nb, scr, F.lane); continue; } r -= I_IN;
        if (r < I_P) { const int kb = r / 64, nb = r % 64; transpose_item(in[2], 2048, WP, 2048, 32 * nb, 0, 64 * kb, 32 * nb, scr, F.lane); continue; } r -= I_P;
        if (r < I_P) { const int kb = r / 64, nb = r % 64; transpose_item(in[3], 2048, WP, 2048, 32 * nb, 1024, 64 * kb, 32 * nb, scr, F.lane); continue; } r -= I_P;
        if (r < I_WO) { const int kb = r / 64, nb = r % 64; transpose_item(in[4], 2048, WO, 2048, 32 * nb, 0, 64 * kb, 32 * nb, scr, F.lane); continue; } r -= I_WO;
        if (r < I_G) { const int kb = r / 176, nb = r % 176, n0 = 32 * nb; transpose_item(in[9], FFH, WGU, 2048, (n0 >> 7) * 256 + (n0 & 127), 0, 64 * kb, n0, scr, F.lane); continue; } r -= I_G;
        if (r < I_G) { const int kb = r / 176, nb = r % 176, n0 = 32 * nb; transpose_item(in[10], FFH, WGU, 2048, (n0 >> 7) * 256 + 128 + (n0 & 127), 0, 64 * kb, n0, scr, F.lane); continue; } r -= I_G;
        { const int kb = r / 64, nb = r % 64; transpose_item(in[11], 2048, WD, FFH, 32 * nb, 0, 64 * kb, 32 * nb, scr, F.lane); }
    }
    const f32x4* x4 = (const f32x4*)in[0]; v4u* xb = (v4u*)(ws + WS_XB);
    for (size_t i = (size_t)F.bid * NTHR + F.tid; i < (size_t)M * DM / 8; i += (size_t)F.G * NTHR) {
        const f32x4 a = x4[2 * i], b = x4[2 * i + 1];
        v4u o; o.x = cvt_pk_bf16(a[0], a[1]); o.y = cvt_pk_bf16(a[2], a[3]); o.z = cvt_pk_bf16(b[0], b[1]); o.w = cvt_pk_bf16(b[2], b[3]);
        xb[i] = o;
    }
}

__device__ __forceinline__ void kmean_item(const Frame& F, int item, const bf16* Z, bf16* KMH, bf16* KML) {
    const int bh = item >> 5, j = item & 31, b = bh >> 3, h = bh & 7;
    LAS float* red = (LAS float*)F.lds;
    const int dp = F.tid & 63, rg = F.tid >> 6;
    const bf16* kp = Z + ((size_t)b * SEQ + 256 * j + 32 * rg) * ZP + ZC_KA + h * HD + 2 * dp;
    float s0 = 0.f, s1 = 0.f;
#pragma unroll 8
    for (int r = 0; r < 32; ++r) { const unsigned w = *(const unsigned*)(kp + (size_t)r * ZP); s0 += bf_lo(w); s1 += bf_hi(w); }
    red[rg * 128 + 2 * dp] = s0; red[rg * 128 + 2 * dp + 1] = s1;
    __syncthreads();
    if (F.tid < 128) { float t = 0.f;
#pragma unroll
        for (int g = 0; g < 8; ++g) t += red[g * 128 + F.tid];
        t *= (1.f / 256.f);
        const unsigned hi = cvt_pk_bf16(t, 0.f) & 0xffffu; const float hf = __uint_as_float(hi << 16);
        const unsigned lo = cvt_pk_bf16(t - hf, 0.f) & 0xffffu;
        KMH[(size_t)item * 128 + F.tid] = (bf16)hi; KML[(size_t)item * 128 + F.tid] = (bf16)lo; }
    __syncthreads();
}
constexpr int HQ_P = 136, HK_P = 72;
constexpr int H_QS = 0, H_KH = 17408, H_KT = 34816, H_VT = 53248, H_DEC = 71680, H_OS = 73728, OS_P = 132;
#define MFMA16K32(a, b, c) __builtin_amdgcn_mfma_f32_16x16x32_bf16((a), (b), (c), 0, 0, 0)
__device__ __forceinline__ f32x4 mfma16k16_pad(s16x4 a, s16x4 b, f32x4 c) {
    const bf16x8 a8 = {a[0], a[1], a[2], a[3], 0, 0, 0, 0}, b8 = {b[0], b[1], b[2], b[3], 0, 0, 0, 0};
    return __builtin_amdgcn_mfma_f32_16x16x32_bf16(a8, b8, c, 0, 0, 0);
}
#define MFMA16K16(a, b, c) mfma16k16_pad((a), (b), (c))
constexpr int HSEG = 16;
template <bool OUT>
__device__ __forceinline__ void hgrn_item(const Frame& F, int item, const bf16* Z, const bf16* VT, const float* lbl, float* ST, float* DC, const float* normg, bf16* OAB) {
    const int bh = item >> 3, sg = item & 7, b = bh >> 3, h = bh & 7;
    const int l15 = F.lane & 15, g = F.lane >> 4, w = F.wave;
    f32x4 S[8];
    f32x4* stp = (f32x4*)ST + ((size_t)item * 64 + w * 8) * 64 + F.lane;
    if (OUT) {
#pragma unroll
        for (int kp = 0; kp < 8; ++kp) S[kp] = stp[kp * 64];
    } else {
#pragma unroll
        for (int kp = 0; kp < 8; ++kp) S[kp] = (f32x4){0.f, 0.f, 0.f, 0.f};
    }
    float dtot = 1.f;
    const int ak = F.tid & 127, aj = F.tid >> 7;
    const float lb = sigm(lbl[h * 128 + ak] - lbl[1024 + h * 128 + ak]);
    unsigned short fraw[16], qraw[16]; v4u vraw[2];
#define HG_LOAD(c_) do { const size_t r0_ = (size_t)b * SEQ + 64 * (c_); \
        const bf16* zq_ = Z + (r0_ + 16 * aj) * ZP + ZC_QB + h * HD + ak; const bf16* zf_ = Z + (r0_ + 16 * aj) * ZP + ZC_FB + h * HD + ak; \
        _Pragma("unroll") for (int i = 0; i < 16; ++i) { fraw[i] = zf_[(size_t)i * ZP]; if (OUT) qraw[i] = zq_[(size_t)i * ZP]; } \
        _Pragma("unroll") for (int i = 0; i < 2; ++i) { const int idx = F.tid + 512 * i; vraw[i] = *(const v4u*)(VT + (size_t)(1024 + h * HD + (idx >> 3)) * M + r0_ + 8 * (idx & 7)); } } while (0)
    HG_LOAD(sg * HSEG);
    const int et = F.tid >> 3, eseg = F.tid & 7;
    f32x4 n0, n1, n2, n3;
    { const float* ng = normg + h * HD + 16 * eseg; n0 = *(const f32x4*)ng; n1 = *(const f32x4*)(ng + 4); n2 = *(const f32x4*)(ng + 8); n3 = *(const f32x4*)(ng + 12); }
#pragma unroll 1
  for (int cc = 0; cc < HSEG; ++cc) {
    const int c = sg * HSEG + cc;
    const size_t row0 = (size_t)b * SEQ + 64 * c;
    LAS bf16* Qs = (LAS bf16*)(F.lds + H_QS); LAS bf16* Kh = (LAS bf16*)(F.lds + H_KH); LAS bf16* Kt = (LAS bf16*)(F.lds + H_KT); LAS bf16* Vt = (LAS bf16*)(F.lds + H_VT);
    LAS float* dec = (LAS float*)(F.lds + H_DEC); LAS float* Os = (LAS float*)(F.lds + H_OS);
    {
        const int k = ak, j = aj;
        float bl[16], ky[16]; float a2 = 0.f;
#pragma unroll
        for (int i = 0; i < 16; ++i) {
            const float fl = bf2f(fraw[i]);
            const float sg_ = sigm(fl), f = lb + (1.f - lb) * sg_;
            a2 += lg2(f); bl[i] = a2; ky[i] = (1.f - lb) * (1.f - sg_);
            if (OUT) {
                const float qv = bf2f(qraw[i]);
                const float ea = ex2(a2);
                const float qt = qv * sigm(qv) * ea, kh = ky[i] * ex2(-a2);
                Qs[(16 * j + i) * HQ_P + k] = (bf16)(cvt_pk_bf16(qt, 0.f) & 0xffffu);
                Kh[(16 * j + i) * HQ_P + k] = (bf16)(cvt_pk_bf16(kh, 0.f) & 0xffffu);
            }
        }
        v4u w0, w1;
        w0.x = cvt_pk_bf16(ky[0] * ex2(a2 - bl[0]), ky[1] * ex2(a2 - bl[1]));     w0.y = cvt_pk_bf16(ky[2] * ex2(a2 - bl[2]), ky[3] * ex2(a2 - bl[3]));
        w0.z = cvt_pk_bf16(ky[4] * ex2(a2 - bl[4]), ky[5] * ex2(a2 - bl[5]));     w0.w = cvt_pk_bf16(ky[6] * ex2(a2 - bl[6]), ky[7] * ex2(a2 - bl[7]));
        w1.x = cvt_pk_bf16(ky[8] * ex2(a2 - bl[8]), ky[9] * ex2(a2 - bl[9]));     w1.y = cvt_pk_bf16(ky[10] * ex2(a2 - bl[10]), ky[11] * ex2(a2 - bl[11]));
        w1.z = cvt_pk_bf16(ky[12] * ex2(a2 - bl[12]), ky[13] * ex2(a2 - bl[13])); w1.w = cvt_pk_bf16(ky[14] * ex2(a2 - bl[14]), ky[15] * ex2(a2 - bl[15]));
        *(LAS v4u*)(Kt + k * HK_P + 16 * j) = w0; *(LAS v4u*)(Kt + k * HK_P + 16 * j + 8) = w1;
        dec[j * 128 + k] = ex2(a2);
#pragma unroll
        for (int i = 0; i < 2; ++i) { const int idx = F.tid + 512 * i, v = idx >> 3, c8 = idx & 7;
            *(LAS v4u*)(Vt + v * HK_P + 8 * c8) = vraw[i]; }
    }
    v4u g0 = {0u, 0u, 0u, 0u}, g1 = {0u, 0u, 0u, 0u};
    if (OUT) { const bf16* og = Z + (row0 + et) * ZP + ZC_OG + h * HD + 16 * eseg; g0 = *(const v4u*)og; g1 = *(const v4u*)(og + 8); }
    __syncthreads();
    if (cc + 1 < HSEG) HG_LOAD(c + 1);
#pragma unroll
    for (int j = 0; j < 4; ++j) {
        const s16x4 vf = *(const LAS s16x4*)(Vt + (16 * w + l15) * HK_P + 16 * j + 4 * g);
        if (OUT) {
            f32x4 at = (f32x4){0.f, 0.f, 0.f, 0.f};
#pragma unroll
            for (int kk = 0; kk < 4; ++kk) {
                const bf16x8 a = *(const LAS bf16x8*)(Kh + (16 * j + l15) * HQ_P + 32 * kk + 8 * g);
                const bf16x8 q = *(const LAS bf16x8*)(Qs + (16 * j + l15) * HQ_P + 32 * kk + 8 * g);
                at = MFMA16K32(a, q, at);
            }
#pragma unroll
            for (int i = 0; i < 4; ++i) if (4 * g + i > l15) at[i] = 0.f;
            v2u atp; atp.x = cvt_pk_bf16(at[0], at[1]); atp.y = cvt_pk_bf16(at[2], at[3]);
            const s16x4 atb = __builtin_bit_cast(s16x4, atp);
            f32x4 o = (f32x4){0.f, 0.f, 0.f, 0.f};
#pragma unroll
            for (int kk = 0; kk < 4; ++kk) {
                const v2u qa = *(const LAS v2u*)(Qs + (16 * j + l15) * HQ_P + 32 * kk + 4 * g);
                const v2u qb = *(const LAS v2u*)(Qs + (16 * j + l15) * HQ_P + 32 * kk + 16 + 4 * g);
                v4u av; av.x = qa.x; av.y = qa.y; av.z = qb.x; av.w = qb.y;
                v4u bv; bv.x = cvt_pk_bf16(S[2 * kk][0], S[2 * kk][1]); bv.y = cvt_pk_bf16(S[2 * kk][2], S[2 * kk][3]);
                bv.z = cvt_pk_bf16(S[2 * kk + 1][0], S[2 * kk + 1][1]); bv.w = cvt_pk_bf16(S[2 * kk + 1][2], S[2 * kk + 1][3]);
                o = MFMA16K32(__builtin_bit_cast(bf16x8, av), __builtin_bit_cast(bf16x8, bv), o);
            }
            o = MFMA16K16(atb, vf, o);
#pragma unroll
            for (int i = 0; i < 4; ++i) Os[(16 * j + 4 * g + i) * OS_P + 16 * w + l15] = o[i];
        }
#pragma unroll
        for (int kp = 0; kp < 8; ++kp) {
            const f32x4 d = *(const LAS f32x4*)(dec + j * 128 + 16 * kp + 4 * g);
            const s16x4 kf = *(const LAS s16x4*)(Kt + (16 * kp + l15) * HK_P + 16 * j + 4 * g);
            S[kp] = MFMA16K16(kf, vf, S[kp] * d);
        }
    }
    if (!OUT) {
        if (F.tid < 128) dtot *= dec[F.tid] * dec[128 + F.tid] * dec[256 + F.tid] * dec[384 + F.tid];
    } else {
        __syncthreads();
        const int t = et, seg = eseg;
        f32x4 x[4]; float ss = 0.f;
#pragma unroll
        for (int i = 0; i < 4; ++i) { x[i] = *(const LAS f32x4*)(Os + t * OS_P + 16 * seg + 4 * i); ss += (x[i][0] * x[i][0] + x[i][1] * x[i][1]) + (x[i][2] * x[i][2] + x[i][3] * x[i][3]); }
        ss += __shfl_xor(ss, 1); ss += __shfl_xor(ss, 2); ss += __shfl_xor(ss, 4);
        const float rstd = __builtin_amdgcn_rsqf(ss * (1.f / 128.f) + RMS_EPS);
        v4u o0, o1;
        o0.x = cvt_pk_bf16(x[0][0] * rstd * n0[0] * sigm(bf_lo(g0.x)), x[0][1] * rstd * n0[1] * sigm(bf_hi(g0.x)));
        o0.y = cvt_pk_bf16(x[0][2] * rstd * n0[2] * sigm(bf_lo(g0.y)), x[0][3] * rstd * n0[3] * sigm(bf_hi(g0.y)));
        o0.z = cvt_pk_bf16(x[1][0] * rstd * n1[0] * sigm(bf_lo(g0.z)), x[1][1] * rstd * n1[1] * sigm(bf_hi(g0.z)));
        o0.w = cvt_pk_bf16(x[1][2] * rstd * n1[2] * sigm(bf_lo(g0.w)), x[1][3] * rstd * n1[3] * sigm(bf_hi(g0.w)));
        o1.x = cvt_pk_bf16(x[2][0] * rstd * n2[0] * sigm(bf_lo(g1.x)), x[2][1] * rstd * n2[1] * sigm(bf_hi(g1.x)));
        o1.y = cvt_pk_bf16(x[2][2] * rstd * n2[2] * sigm(bf_lo(g1.y)), x[2][3] * rstd * n2[3] * sigm(bf_hi(g1.y)));
        o1.z = cvt_pk_bf16(x[3][0] * rstd * n3[0] * sigm(bf_lo(g1.z)), x[3][1] * rstd * n3[1] * sigm(bf_hi(g1.z)));
        o1.w = cvt_pk_bf16(x[3][2] * rstd * n3[2] * sigm(bf_lo(g1.w)), x[3][3] * rstd * n3[3] * sigm(bf_hi(g1.w)));
        bf16* op = OAB + (row0 + t) * DM + 1024 + h * HD + 16 * seg;
        *(v4u*)op = o0; *(v4u*)(op + 8) = o1;
    }
    __syncthreads();
  }
    if (!OUT) {
#pragma unroll
        for (int kp = 0; kp < 8; ++kp) stp[kp * 64] = S[kp];
        if (F.tid < 128) DC[(size_t)item * 128 + F.tid] = dtot;
    }
}
__device__ __forceinline__ void hgrn_scan(const Frame& F, float* ST, const float* DC) {
    for (int gid = F.bid * NTHR + F.tid; gid < 32 * 4096; gid += F.G * NTHR) {
        const int bh = gid >> 12, q = gid & 4095, kp = (q >> 6) & 7, ln = q & 63, k0 = 16 * kp + 4 * (ln >> 4);
        f32x4* sp = (f32x4*)ST + (size_t)bh * 8 * 4096 + q; const f32x4* dp = (const f32x4*)(DC + (size_t)bh * 8 * 128 + k0);
        f32x4 s = (f32x4){0.f, 0.f, 0.f, 0.f};
#pragma unroll
        for (int c = 0; c < 8; ++c) { const f32x4 u = sp[(size_t)c * 4096]; const f32x4 d = dp[c * 32]; sp[(size_t)c * 4096] = s; s = d * s + u; }
    }
}
constexpr int AK_P = 136, AV_P = 72;
constexpr int A_QS = 71680;
constexpr int A_KS = 0, A_VS = 2 * 64 * AK_P * 2  , A_KSZ = 64 * AK_P * 2, A_VSZ = 128 * AV_P * 2;
#define MFMA32(a, b, c) __builtin_amdgcn_mfma_f32_32x32x16_bf16((a), (b), (c), 0, 0, 0)
__device__ __forceinline__ void attn_unit(const Frame& F, int bh, int n, const bf16* Z, const bf16* VT, const bf16* KMH, const bf16* KML, bf16* OAB) {
    const int b = bh >> 3, h = bh & 7, w = F.wave, q32 = F.lane & 31, hi = F.lane >> 5;
    const size_t rowb = (size_t)b * SEQ;
    const int qpos = 32 * w + q32;
    constexpr float C2 = 0.08838834764831845f * 1.4426950408889634f;
    constexpr float NEG = -1e30f;
    bf16x8 qr[8];
    { const bf16* qp = Z + (rowb + 256 * n + qpos) * ZP + ZC_QA + h * HD + 8 * hi;
#pragma unroll
      for (int s = 0; s < 8; ++s) qr[s] = *(const bf16x8*)(qp + 16 * s); }
    unsigned bmask = 0u;
    if (n > 0) {
        f32x16 gt = {};
        const bf16* kh = KMH + ((size_t)bh * 32 + q32) * 128 + 8 * hi; const bf16* kl = KML + ((size_t)bh * 32 + q32) * 128 + 8 * hi;
#pragma unroll
        for (int s = 0; s < 8; ++s) { const bf16x8 a = *(const bf16x8*)(kh + 16 * s), a2 = *(const bf16x8*)(kl + 16 * s); gt = MFMA32(a, qr[s], gt); gt = MFMA32(a2, qr[s], gt); }
        float gv[16];
#pragma unroll
        for (int r = 0; r < 16; ++r) gv[r] = (crow(r, hi) < n) ? gt[r] : -INFINITY;
#pragma unroll
        for (int round = 0; round < 3; ++round) {
            float bv = -INFINITY; int bj = 99;
#pragma unroll
            for (int r = 0; r < 16; ++r) if (gv[r] > bv) { bv = gv[r]; bj = crow(r, hi); }
            const float pv = __shfl_xor(bv, 32); const int pj = __shfl_xor(bj, 32);
            const bool mine = (bv > pv) || (bv == pv && bj < pj);
            const float wv = mine ? bv : pv; const int wj = mine ? bj : pj;
            if (wv > -INFINITY) bmask |= 1u << wj;
            if (mine) {
#pragma unroll
                for (int r = 0; r < 16; ++r) if (crow(r, hi) == bj) gv[r] = -INFINITY;
            }
        }
    }
    LAS bf16x8* qs = (LAS bf16x8*)(F.lds + A_QS) + (w * 8) * 64 + F.lane;
#pragma unroll
    for (int s = 0; s < 8; ++s) qs[s * 64] = qr[s];
    f32x16 O[4]; O[0] = f32x16{}; O[1] = f32x16{}; O[2] = f32x16{}; O[3] = f32x16{};
    float mrow = NEG, lrow = 0.f;
    const int NT = 4 + 4 * n;
    const bf16* Kg = Z + rowb * ZP + ZC_KA + h * HD;
    const bf16* Vg = VT + (size_t)(h * HD) * M + rowb;
    v4u kst[2], vst[2];
#define A_LOAD(t_) do { const int kr0_ = ((t_) < 4) ? 256 * n + 64 * (t_) : 64 * ((t_) - 4); \
        _Pragma("unroll") for (int i_ = 0; i_ < 2; ++i_) { const int idx_ = F.tid + 512 * i_; \
            kst[i_] = *(const v4u*)(Kg + (size_t)(kr0_ + (idx_ >> 4)) * ZP + 8 * (idx_ & 15)); \
            vst[i_] = *(const v4u*)(Vg + (size_t)(idx_ >> 3) * M + kr0_ + 8 * (idx_ & 7)); } } while (0)
#define A_STORE(buf_) do { _Pragma("unroll") for (int i_ = 0; i_ < 2; ++i_) { const int idx_ = F.tid + 512 * i_; \
            *(LAS v4u*)(F.lds + A_KS + (buf_) * A_KSZ + ((idx_ >> 4) * AK_P + 8 * (idx_ & 15)) * 2) = kst[i_]; \
            *(LAS v4u*)(F.lds + A_VS + (buf_) * A_VSZ + ((idx_ >> 3) * AV_P + 8 * (idx_ & 7)) * 2) = vst[i_]; } } while (0)
    A_LOAD(0); A_STORE(0);
    __syncthreads();
    for (int t = 0; t < NT; ++t) {
        const int buf = t & 1;
        if (t + 1 < NT) A_LOAD(t + 1);
        bool need; int jblk = 0;
        if (t < 4) need = (64 * t <= 32 * w + 31);
        else { jblk = (t - 4) >> 2; need = __ballot((bmask >> jblk) & 1u) != 0ull; }
        if (need) {
            const LAS unsigned char* Kb = F.lds + A_KS + buf * A_KSZ; const LAS unsigned char* Vb = F.lds + A_VS + buf * A_VSZ;
            f32x16 p0 = {}, p1 = {};
#pragma unroll
            for (int s = 0; s < 8; ++s) {
                const bf16x8 a0 = *(const LAS bf16x8*)(Kb + (q32 * AK_P + 16 * s + 8 * hi) * 2);
                const bf16x8 a1 = *(const LAS bf16x8*)(Kb + ((32 + q32) * AK_P + 16 * s + 8 * hi) * 2);
                const bf16x8 qf = qs[s * 64];
                p0 = MFMA32(a0, qf, p0); p1 = MFMA32(a1, qf, p1);
            }
            if (t < 4) {
                const int kb0 = 64 * t;
#pragma unroll
                for (int r = 0; r < 16; ++r) { const int kp = kb0 + crow(r, hi);
                    p0[r] = (kp <= qpos) ? p0[r] * C2 : NEG; p1[r] = (kp + 32 <= qpos) ? p1[r] * C2 : NEG; }
            } else {
                const bool sel = (bmask >> jblk) & 1u;
#pragma unroll
                for (int r = 0; r < 16; ++r) { p0[r] = sel ? p0[r] * C2 : NEG; p1[r] = sel ? p1[r] * C2 : NEG; }
            }
            float mt = p0[0];
#pragma unroll
            for (int r = 1; r < 16; ++r) mt = fmaxf(mt, p0[r]);
#pragma unroll
            for (int r = 0; r < 16; ++r) mt = fmaxf(mt, p1[r]);
            mt = fmaxf(mt, __shfl_xor(mt, 32));
            const float mn = fmaxf(mrow, mt), alpha = ex2(mrow - mn);
            mrow = mn;
            float ls = 0.f;
#pragma unroll
            for (int r = 0; r < 16; ++r) { p0[r] = ex2(p0[r] - mn); p1[r] = ex2(p1[r] - mn); ls += p0[r] + p1[r]; }
            lrow = lrow * alpha + ls;
#pragma unroll
            for (int d = 0; d < 4; ++d) O[d] *= alpha;
            bf16x8 pb[2][2];
#pragma unroll
            for (int s = 0; s < 2; ++s) {
                v4u x0, x1;
                x0.x = cvt_pk_bf16(p0[8 * s + 0], p0[8 * s + 1]); x0.y = cvt_pk_bf16(p0[8 * s + 2], p0[8 * s + 3]); x0.z = cvt_pk_bf16(p0[8 * s + 4], p0[8 * s + 5]); x0.w = cvt_pk_bf16(p0[8 * s + 6], p0[8 * s + 7]);
                x1.x = cvt_pk_bf16(p1[8 * s + 0], p1[8 * s + 1]); x1.y = cvt_pk_bf16(p1[8 * s + 2], p1[8 * s + 3]); x1.z = cvt_pk_bf16(p1[8 * s + 4], p1[8 * s + 5]); x1.w = cvt_pk_bf16(p1[8 * s + 6], p1[8 * s + 7]);
                pb[0][s] = __builtin_bit_cast(bf16x8, x0); pb[1][s] = __builtin_bit_cast(bf16x8, x1);
            }
#pragma unroll
            for (int d = 0; d < 4; ++d)
#pragma unroll
                for (int sub = 0; sub < 2; ++sub)
#pragma unroll
                    for (int s = 0; s < 2; ++s) {
                        const LAS unsigned char* vp = Vb + ((32 * d + q32) * AV_P + 32 * sub + 16 * s + 4 * hi) * 2;
                        const v2u lo = *(const LAS v2u*)vp, hh = *(const LAS v2u*)(vp + 16);
                        v4u av; av.x = lo.x; av.y = lo.y; av.z = hh.x; av.w = hh.y;
                        O[d] = MFMA32(__builtin_bit_cast(bf16x8, av), pb[sub][s], O[d]);
                    }
        }
        if (t + 1 < NT) A_STORE(buf ^ 1);
        __syncthreads();
    }
#undef A_LOAD
#undef A_STORE
    const float lt = lrow + __shfl_xor(lrow, 32);
    const float inv = 1.f / lt;
    bf16* op = OAB + (rowb + 256 * n + qpos) * DM + h * HD + 4 * hi;
#pragma unroll
    for (int d = 0; d < 4; ++d)
#pragma unroll
        for (int r4 = 0; r4 < 4; ++r4) {
            v2u o; o.x = cvt_pk_bf16(O[d][4 * r4] * inv, O[d][4 * r4 + 1] * inv); o.y = cvt_pk_bf16(O[d][4 * r4 + 2] * inv, O[d][4 * r4 + 3] * inv);
            *(v2u*)(op + 32 * d + 8 * r4) = o;
        }
}
constexpr int GK_P = 136, GV_P = 264;
constexpr int G_KS = 0, G_VS = 256 * GK_P * 2  , G_MISC = G_VS + 128 * GV_P * 2  ;
constexpr int N_UNITS = 32 * 32;
__device__ __forceinline__ unsigned moba_mask(const Frame& F, int bh, int n, const bf16x8 (&qr)[8], const bf16* KMH, const bf16* KML) {
    const int q32 = F.lane & 31, hi = F.lane >> 5;
    unsigned bmask = 0u;
    if (n > 0) {
        f32x16 gt = {};
        const bf16* kh = KMH + ((size_t)bh * 32 + q32) * 128 + 8 * hi; const bf16* kl = KML + ((size_t)bh * 32 + q32) * 128 + 8 * hi;
#pragma unroll
        for (int s = 0; s < 8; ++s) { const bf16x8 a = *(const bf16x8*)(kh + 16 * s), a2 = *(const bf16x8*)(kl + 16 * s); gt = MFMA32(a, qr[s], gt); gt = MFMA32(a2, qr[s], gt); }
        float gv[16];
#pragma unroll
        for (int r = 0; r < 16; ++r) gv[r] = (crow(r, hi) < n) ? gt[r] : -INFINITY;
#pragma unroll
        for (int round = 0; round < 3; ++round) {
            float bv = -INFINITY; int bj = 99;
#pragma unroll
            for (int r = 0; r < 16; ++r) if (gv[r] > bv) { bv = gv[r]; bj = crow(r, hi); }
            const float pv = __shfl_xor(bv, 32); const int pj = __shfl_xor(bj, 32);
            const bool mine = (bv > pv) || (bv == pv && bj < pj);
            const float wv = mine ? bv : pv; const int wj = mine ? bj : pj;
            if (wv > -INFINITY) bmask |= 1u << wj;
            if (mine) {
#pragma unroll
                for (int r = 0; r < 16; ++r) if (crow(r, hi) == bj) gv[r] = -INFINITY;
            }
        }
    }
    return bmask;
}
__device__ __forceinline__ void gate_unit(const Frame& F, int bh, int n, const bf16* Z, const bf16* KMH, const bf16* KML, unsigned* CNT, unsigned* LIST) {
    const int b = bh >> 3, h = bh & 7, q32 = F.lane & 31, hi = F.lane >> 5;
    const int t = 256 * n + 32 * F.wave + q32;
    bf16x8 qr[8];
    { const bf16* qp = Z + ((size_t)b * SEQ + t) * ZP + ZC_QA + h * HD + 8 * hi;
#pragma unroll
      for (int s = 0; s < 8; ++s) qr[s] = *(const bf16x8*)(qp + 16 * s); }
    const unsigned bmask = moba_mask(F, bh, n, qr, KMH, KML);
    LAS unsigned* cl = (LAS unsigned*)F.lds;
    if (F.tid < 64) cl[F.tid] = 0u;
    __syncthreads();
    unsigned m = (hi == 0) ? bmask : 0u;
    int jsel[3]; unsigned posl[3];
#pragma unroll
    for (int r = 0; r < 3; ++r) {
        jsel[r] = -1; posl[r] = 0u;
        if (m != 0u) { const int jj = __ffs((int)m) - 1; m &= m - 1u; jsel[r] = jj; posl[r] = __hip_atomic_fetch_add(cl + jj, 1u, __ATOMIC_RELAXED, __HIP_MEMORY_SCOPE_WORKGROUP); }
    }
    __syncthreads();
    if (F.tid < n) { const unsigned c = cl[F.tid]; cl[32 + F.tid] = c ? atomicAdd(CNT + bh * 32 + F.tid, c) : 0u; }
    __syncthreads();
#pragma unroll
    for (int r = 0; r < 3; ++r) if (jsel[r] >= 0) LIST[((size_t)bh * 32 + jsel[r]) * 8192 + cl[32 + jsel[r]] + posl[r]] = (unsigned)t | ((unsigned)r << 13);
    __syncthreads();
}
#define G_TILE(tile_, MODE_, qpos_) do { \
        f32x16 p0 = {}, p1 = {}; \
        _Pragma("unroll") for (int s = 0; s < 8; ++s) { \
            const bf16x8 a0 = *(const LAS bf16x8*)(F.lds + G_KS + ((64 * (tile_) + q32) * GK_P + 16 * s + 8 * hi) * 2); \
            const bf16x8 a1 = *(const LAS bf16x8*)(F.lds + G_KS + ((64 * (tile_) + 32 + q32) * GK_P + 16 * s + 8 * hi) * 2); \
            p0 = MFMA32(a0, qr[s], p0); p1 = MFMA32(a1, qr[s], p1); } \
        if (MODE_) { const int kb0 = 64 * (tile_); \
            _Pragma("unroll") for (int r = 0; r < 16; ++r) { const int kp = kb0 + crow(r, hi); \
                p0[r] = (kp <= (qpos_)) ? p0[r] * C2 : NEG; p1[r] = (kp + 32 <= (qpos_)) ? p1[r] * C2 : NEG; } } \
        else { _Pragma("unroll") for (int r = 0; r < 16; ++r) { p0[r] *= C2; p1[r] *= C2; } } \
        float mt = p0[0]; \
        _Pragma("unroll") for (int r = 1; r < 16; ++r) mt = fmaxf(mt, p0[r]); \
        _Pragma("unroll") for (int r = 0; r < 16; ++r) mt = fmaxf(mt, p1[r]); \
        mt = fmaxf(mt, __shfl_xor(mt, 32)); \
        const float mn = fmaxf(mrow, mt), alpha = ex2(mrow - mn); \
        mrow = mn; \
        float ls = 0.f; \
        _Pragma("unroll") for (int r = 0; r < 16; ++r) { p0[r] = ex2(p0[r] - mn); p1[r] = ex2(p1[r] - mn); ls += p0[r] + p1[r]; } \
        lrow = lrow * alpha + ls; \
        if (__ballot(alpha != 1.f) != 0ull) { _Pragma("unroll") for (int d = 0; d < 4; ++d) O[d] *= alpha; } \
        bf16x8 pb[2][2]; \
        _Pragma("unroll") for (int s = 0; s < 2; ++s) { v4u x0, x1; \
            x0.x = cvt_pk_bf16(p0[8 * s + 0], p0[8 * s + 1]); x0.y = cvt_pk_bf16(p0[8 * s + 2], p0[8 * s + 3]); x0.z = cvt_pk_bf16(p0[8 * s + 4], p0[8 * s + 5]); x0.w = cvt_pk_bf16(p0[8 * s + 6], p0[8 * s + 7]); \
            x1.x = cvt_pk_bf16(p1[8 * s + 0], p1[8 * s + 1]); x1.y = cvt_pk_bf16(p1[8 * s + 2], p1[8 * s + 3]); x1.z = cvt_pk_bf16(p1[8 * s + 4], p1[8 * s + 5]); x1.w = cvt_pk_bf16(p1[8 * s + 6], p1[8 * s + 7]); \
            pb[0][s] = __builtin_bit_cast(bf16x8, x0); pb[1][s] = __builtin_bit_cast(bf16x8, x1); } \
        _Pragma("unroll") for (int d = 0; d < 4; ++d) \
        _Pragma("unroll") for (int sub = 0; sub < 2; ++sub) \
        _Pragma("unroll") for (int s = 0; s < 2; ++s) { \
            const LAS unsigned char* vp = F.lds + G_VS + ((32 * d + q32) * GV_P + 64 * (tile_) + 32 * sub + 16 * s + 4 * hi) * 2; \
            const v2u lo = *(const LAS v2u*)vp, hh = *(const LAS v2u*)(vp + 16); \
            v4u av; av.x = lo.x; av.y = lo.y; av.z = hh.x; av.w = hh.y; \
            O[d] = MFMA32(__builtin_bit_cast(bf16x8, av), pb[sub][s], O[d]); } \
    } while (0)
#define G_WRITE(t_, slot_, valid_) do { \
        const float lt = lrow + __shfl_xor(lrow, 32); const float inv = 1.f / lt; \
        if (valid_) { const size_t prow = ((size_t)bh * SEQ + (t_)) * 4 + (slot_); \
            bf16* pp = PO + prow * 128 + 4 * hi; \
            _Pragma("unroll") for (int d = 0; d < 4; ++d) \
            _Pragma("unroll") for (int r4 = 0; r4 < 4; ++r4) { v2u o; o.x = cvt_pk_bf16(O[d][4 * r4] * inv, O[d][4 * r4 + 1] * inv); o.y = cvt_pk_bf16(O[d][4 * r4 + 2] * inv, O[d][4 * r4 + 3] * inv); \
                *(v2u*)(pp + 32 * d + 8 * r4) = o; } \
            if (hi == 0) { f32x2 ml; ml.x = mrow; ml.y = lt; *(f32x2*)(PML + 2 * prow) = ml; } } \
    } while (0)
__device__ __forceinline__ void attn_queue(const Frame& F, const bf16* Z, const bf16* VT, const unsigned* CNT, unsigned* QCTR, const unsigned* LIST, bf16* PO, float* PML) {
    const int q32 = F.lane & 31, hi = F.lane >> 5, w = F.wave;
    constexpr float C2 = 0.08838834764831845f * 1.4426950408889634f;
    constexpr float NEG = -1e30f;
    LAS unsigned* misc = (LAS unsigned*)(F.lds + G_MISC);
    for (;;) {
        if (F.tid == 0) misc[0] = atomicAdd(QCTR, 1u);
        __syncthreads();
        const int u = (int)misc[0];
        if (u >= N_UNITS) break;
        const int bh = u & 31, blk = u >> 5;
        const int b = bh >> 3, h = bh & 7;
        const size_t rowb = (size_t)b * SEQ;
        { const bf16* Kg = Z + (rowb + 256 * blk) * ZP + ZC_KA + h * HD; const bf16* Vg = VT + (size_t)(h * HD) * M + rowb + 256 * blk;
#pragma unroll 4
          for (int i = 0; i < 8; ++i) { const int idx = F.tid + 512 * i;
              const v4u kv = *(const v4u*)(Kg + (size_t)(idx >> 4) * ZP + 8 * (idx & 15));
              const v4u vv = *(const v4u*)(Vg + (size_t)(idx >> 5) * M + 8 * (idx & 31));
              *(LAS v4u*)(F.lds + G_KS + ((idx >> 4) * GK_P + 8 * (idx & 15)) * 2) = kv;
              *(LAS v4u*)(F.lds + G_VS + ((idx >> 5) * GV_P + 8 * (idx & 31)) * 2) = vv; } }
        __syncthreads();
        {
            const int cntj = (int)CNT[bh * 32 + blk]; const unsigned* lst = LIST + ((size_t)bh * 32 + blk) * 8192;
            const int nch = (cntj + 31) >> 5;
#define G_ENTRY(c_) lst[(32 * (c_) + q32 < cntj) ? 32 * (c_) + q32 : 32 * (c_)]
            unsigned e_cur = 0u;
            if (w < nch) e_cur = G_ENTRY(w);
            for (int c = w; c < nch; c += NWAVES) {
                const bool valid = 32 * c + q32 < cntj;
                const int t = (int)(e_cur & 8191u), slot = (int)(e_cur >> 13);
                unsigned e_nxt = 0u; if (c + NWAVES < nch) e_nxt = G_ENTRY(c + NWAVES);
                bf16x8 qr[8];
                { const bf16* qp = Z + (rowb + t) * ZP + ZC_QA + h * HD + 8 * hi;
#pragma unroll
                  for (int s = 0; s < 8; ++s) qr[s] = *(const bf16x8*)(qp + 16 * s); }
                f32x16 O[4]; O[0] = f32x16{}; O[1] = f32x16{}; O[2] = f32x16{}; O[3] = f32x16{};
                float mrow = NEG, lrow = 0.f;
#pragma unroll 1
                for (int tile = 0; tile < 4; ++tile) G_TILE(tile, 0, 0);
                G_WRITE(t, slot, valid);
                e_cur = e_nxt;
            }
#undef G_ENTRY
        }
        {
            const int qpos = 32 * w + q32, t = 256 * blk + qpos;
            bf16x8 qr[8];
            { const bf16* qp = Z + (rowb + t) * ZP + ZC_QA + h * HD + 8 * hi;
#pragma unroll
              for (int s = 0; s < 8; ++s) qr[s] = *(const bf16x8*)(qp + 16 * s); }
            f32x16 O[4]; O[0] = f32x16{}; O[1] = f32x16{}; O[2] = f32x16{}; O[3] = f32x16{};
            float mrow = NEG, lrow = 0.f;
#pragma unroll 1
            for (int tile = 0; tile < 4; ++tile) { if (64 * tile <= 32 * w + 31) G_TILE(tile, 1, qpos); }
            G_WRITE(t, 3, true);
        }
        __syncthreads();
    }
}
__device__ __forceinline__ void attn_combine(const Frame& F, const bf16* PO, const float* PML, bf16* OAB) {
    const int rsub = F.lane >> 4, c16 = F.lane & 15;
    for (int row0 = (F.bid * NWAVES + F.wave) * 8; row0 < 32 * SEQ; row0 += F.G * NWAVES * 8) {
#pragma unroll
        for (int rr = 0; rr < 2; ++rr) {
            const int row = row0 + 4 * rr + rsub;
            const int bh = row >> 13, t = row & 8191, n = t >> 8, ns = n < 3 ? n : 3;
            const f32x4* ml4 = (const f32x4*)PML + (size_t)row * 2;
            const f32x4 mA = ml4[0], mB = ml4[1];
            const float m0 = ns > 0 ? mA[0] : -1e30f, m1 = ns > 1 ? mA[2] : -1e30f, m2 = ns > 2 ? mB[0] : -1e30f, m3 = mB[2];
            const float mx = fmaxf(fmaxf(m0, m1), fmaxf(m2, m3));
            const float w0 = ns > 0 ? mA[1] * ex2(m0 - mx) : 0.f, w1 = ns > 1 ? mA[3] * ex2(m1 - mx) : 0.f, w2 = ns > 2 ? mB[1] * ex2(m2 - mx) : 0.f, w3 = mB[3] * ex2(m3 - mx);
            const float inv = 1.f / (w0 + w1 + w2 + w3);
            const v4u* po = (const v4u*)(PO + (size_t)row * 4 * 128) + c16;
            const v4u z4 = {0u, 0u, 0u, 0u};
            const v4u p3 = po[48], p0 = ns > 0 ? po[0] : z4, p1 = ns > 1 ? po[16] : z4, p2 = ns > 2 ? po[32] : z4;
            v4u o;
#define CMB(c) cvt_pk_bf16((w0 * bf_lo(p0.c) + w1 * bf_lo(p1.c) + w2 * bf_lo(p2.c) + w3 * bf_lo(p3.c)) * inv, (w0 * bf_hi(p0.c) + w1 * bf_hi(p1.c) + w2 * bf_hi(p2.c) + w3 * bf_hi(p3.c)) * inv)
            o.x = CMB(x); o.y = CMB(y); o.z = CMB(z); o.w = CMB(w);
#undef CMB
            *(v4u*)(OAB + ((size_t)(bh >> 3) * SEQ + t) * DM + (bh & 7) * HD + 8 * c16) = o;
        }
    }
}
__device__ __forceinline__ void ln1_row(int lane, const float* xrow, const bf16* mrow, const float* g, const float* bb, bf16* orow) {
    const f32x4* xr = (const f32x4*)xrow + lane; const v2u* mr = (const v2u*)mrow + lane;
    f32x4 v[8]; float s = 0.f;
#pragma unroll
    for (int j = 0; j < 8; ++j) { const f32x4 xv = xr[64 * j]; const v2u mv = mr[64 * j];
        v[j][0] = xv[0] * ALPHA + bf_lo(mv.x); v[j][1] = xv[1] * ALPHA + bf_hi(mv.x); v[j][2] = xv[2] * ALPHA + bf_lo(mv.y); v[j][3] = xv[3] * ALPHA + bf_hi(mv.y);
        s += (v[j][0] + v[j][1]) + (v[j][2] + v[j][3]); }
    const float mean = wave_sum(s) * (1.f / DM); float s2 = 0.f;
#pragma unroll
    for (int j = 0; j < 8; ++j) { const f32x4 d = v[j] - mean; s2 += (d[0] * d[0] + d[1] * d[1]) + (d[2] * d[2] + d[3] * d[3]); }
    const float rstd = 1.f / sqrtf(wave_sum(s2) * (1.f / DM) + LN_EPS);
    v2u* o8 = (v2u*)orow + lane;
#pragma unroll
    for (int j = 0; j < 8; ++j) { const f32x4 gg = ((const f32x4*)g)[64 * j + lane], b4 = ((const f32x4*)bb)[64 * j + lane];
        const f32x4 y = (v[j] - mean) * rstd * gg + b4; v2u o; o.x = cvt_pk_bf16(y[0], y[1]); o.y = cvt_pk_bf16(y[2], y[3]); o8[64 * j] = o; }
}
__device__ __forceinline__ void ln2_row(int lane, const bf16* prow, float* row, const float* g, const float* bb) {
    const v2u* pr = (const v2u*)prow + lane; f32x4* xr = (f32x4*)row + lane;
    f32x4 v[8]; float s = 0.f;
#pragma unroll
    for (int j = 0; j < 8; ++j) { const v2u pv = pr[64 * j]; v[j][0] = bf_lo(pv.x); v[j][1] = bf_hi(pv.x); v[j][2] = bf_lo(pv.y); v[j][3] = bf_hi(pv.y); s += (v[j][0] + v[j][1]) + (v[j][2] + v[j][3]); }
    const float mean = wave_sum(s) * (1.f / DM); float s2 = 0.f;
#pragma unroll
    for (int j = 0; j < 8; ++j) { const f32x4 d = v[j] - mean; s2 += (d[0] * d[0] + d[1] * d[1]) + (d[2] * d[2] + d[3] * d[3]); }
    const float rstd = 1.f / sqrtf(wave_sum(s2) * (1.f / DM) + LN_EPS);
#pragma unroll
    for (int j = 0; j < 8; ++j) { const f32x4 gg = ((const f32x4*)g)[64 * j + lane], b4 = ((const f32x4*)bb)[64 * j + lane]; xr[64 * j] = (v[j] - mean) * rstd * gg + b4; }
}

typedef unsigned gu32;
#define XB_TMO      128
#define XB_XCNT(j)  (256  + 64 * (j))
#define XB_XSUB(j)  (1280 + 64 * (j))
#define XB_XGEN(j)  (2304 + 64 * (j))
#define XB_TOP      3328
#define XB_TOPGEN   3392
#define XCD_BAR_WORDS 3456
#define XB_SPIN_CAP (1u << 18)

__device__ __forceinline__ unsigned xb_ld(unsigned* p)              { return __hip_atomic_load(p, __ATOMIC_RELAXED, __HIP_MEMORY_SCOPE_AGENT); }
__device__ __forceinline__ unsigned xb_add(unsigned* p, unsigned v) { return __hip_atomic_fetch_add(p, v, __ATOMIC_RELAXED, __HIP_MEMORY_SCOPE_AGENT); }
__device__ __forceinline__ unsigned xb_xcc_id() { return (unsigned)__builtin_amdgcn_s_getreg((3 << 11) | 20) & 0xFu; }
#define XB_SPIN(cond, bar) do { unsigned _sp = 0; while (cond) { __builtin_amdgcn_s_sleep(1); \
    if ((++_sp & 255u) == 0u) { if (xb_ld(&(bar)[XB_TMO])) break; if (_sp > XB_SPIN_CAP) { atomicAdd(&(bar)[XB_TMO], 1u); break; } } } } while (0)

struct XcdBarrier {
    unsigned* bar; unsigned x;
    volatile LAS unsigned* st;
};

__device__ __forceinline__ XcdBarrier xcd_barrier_post(unsigned* bar, volatile LAS unsigned* st) {
    XcdBarrier b; b.bar = bar; b.x = xb_xcc_id(); b.st = st;
    if (threadIdx.x == 0) (void)xb_add(&bar[XB_XCNT(b.x)], 1u);
    return b;
}
__device__ __forceinline__ void xcd_barrier_complete(unsigned* bar, unsigned x, unsigned& nloc, unsigned& nx) {
    const unsigned G = gridDim.x * gridDim.y * gridDim.z;
    unsigned sum, cnt, mine, sp = 0u;
    for (;;) {
        sum = 0u; cnt = 0u; mine = 0u;
#pragma unroll
        for (unsigned j = 0; j < 16; ++j) { const unsigned c = xb_ld(&bar[XB_XCNT(j)]); sum += c; cnt += (c > 0u) ? 1u : 0u; mine = (j == x) ? c : mine; }
        if (sum == G) break;
        __builtin_amdgcn_s_sleep(1);
        if ((++sp & 255u) == 0u) { if (xb_ld(&bar[XB_TMO])) break; if (sp > XB_SPIN_CAP) { atomicAdd(&bar[XB_TMO], 1u); break; } }
    }
    nloc = mine > 0u ? mine : 1u; nx = cnt > 0u ? cnt : 1u;
}

__device__ __forceinline__ void xcd_barrier(const XcdBarrier& b) {
    asm volatile("s_waitcnt vmcnt(0)" ::: "memory");
    __syncthreads();
    if (threadIdx.x == 0) {
        unsigned* bar = b.bar;
        __builtin_amdgcn_s_waitcnt(0);
        unsigned nloc = b.st[0], nx = b.st[1];
        if (nloc == 0u) { xcd_barrier_complete(bar, b.x, nloc, nx); b.st[0] = nloc; b.st[1] = nx; }
        const unsigned old = xb_add(&bar[XB_XSUB(b.x)], 1u);
        const unsigned gen = old / nloc;
        if (old + 1u == (gen + 1u) * nloc) {
            __builtin_amdgcn_fence(__ATOMIC_RELEASE, "agent");
            asm volatile("s_waitcnt vmcnt(0)" ::: "memory");
            const unsigned og = xb_add(&bar[XB_TOP], 1u);
            const unsigned tg = og / nx;
            if (og + 1u == (tg + 1u) * nx) xb_add(&bar[XB_TOPGEN], 1u);
            else XB_SPIN(xb_ld(&bar[XB_TOPGEN]) == tg, bar);
            __builtin_amdgcn_fence(__ATOMIC_ACQUIRE, "agent");
            xb_add(&bar[XB_XGEN(b.x)], 1u);
            asm volatile("s_waitcnt vmcnt(0)" ::: "memory");
        } else {
            XB_SPIN(xb_ld(&bar[XB_XGEN(b.x)]) == gen, bar);
            __builtin_amdgcn_fence(__ATOMIC_ACQUIRE, "agent");
            asm volatile("s_waitcnt vmcnt(0)" ::: "memory");
        }
    }
    __syncthreads();
}

struct Args { const float* in[14]; float* out; unsigned char* ws; int ph_lo, ph_hi; };
__global__ void __launch_bounds__(NTHR, 2) fwd_kernel(Args args) {
    extern __shared__ __attribute__((aligned(16))) unsigned char lds_raw[];
    Frame F; F.lds = (LAS unsigned char*)lds_raw; F.tid = threadIdx.x; F.lane = F.tid & 63; F.wave = __builtin_amdgcn_readfirstlane(F.tid >> 6); F.G = gridDim.x; F.bid = blockIdx.x;
    unsigned char* ws = args.ws;
    const int lo = args.ph_lo, hi = args.ph_hi;
#ifndef PHMASK
#define PHMASK 0x1fff
#endif
#define IN(k) ((((PHMASK) >> (k)) & 1) && lo <= (k) && (k) < hi)
    volatile LAS unsigned* bst = (volatile LAS unsigned*)(F.lds + LDS_BYTES - 64);
    if (F.tid < 2) bst[F.tid] = 0u;
    __syncthreads();
    const XcdBarrier xbar = xcd_barrier_post((unsigned*)(ws + WS_BAR), bst);
#define SEAM(k) do { if (IN(k) && IN((k) + 1)) { if (hi > NPHASE) cg::this_grid().sync();   else xcd_barrier(xbar); } } while (0)
    bf16* WIN = (bf16*)(ws + WS_WIN); bf16* WP = (bf16*)(ws + WS_WP); bf16* WO = (bf16*)(ws + WS_WO); bf16* WGU = (bf16*)(ws + WS_WGU); bf16* WD = (bf16*)(ws + WS_WD);
    bf16* XB = (bf16*)(ws + WS_XB); bf16* Zb = (bf16*)(ws + WS_Z); bf16* VT = (bf16*)(ws + WS_VT); bf16* OAB = (bf16*)(ws + WS_OAB);
    bf16* KMH = (bf16*)(ws + WS_KMH); bf16* KML = (bf16*)(ws + WS_KML); float* DC = (float*)(ws + WS_DC);
    float* ST = (float*)(ws + WS_WIN);
    unsigned* CNT = (unsigned*)(ws + WS_CNT); unsigned* LIST = (unsigned*)(ws + WS_LIST); float* PML = (float*)(ws + WS_PML);
    bf16* MIX = (bf16*)(ws + WS_PRE1); bf16* PRE2 = (bf16*)(ws + WS_PRE1);   bf16* ACT = (bf16*)(ws + WS_ACT); bf16* MERGED = (bf16*)(ws + WS_MERGED); bf16* H1N = (bf16*)(ws + WS_H1N);

    if (IN(0)) { p0_prologue(F, args.in, ws); }
    SEAM(0);
    if (IN(1)) {
        { pg8::Gemm g{XB, WIN, M, ZP, DM}; pg8::StaticOrder S; S.init(M, ZP, F.G, F.bid);
          pg8::EpiBf16<0> E{Zb, ZP, nullptr, 0, 0, 1.f};
          pg8::gemm_phase<pg8::EpiBf16<0>, pg8::StaticOrder, PG8_ALIGN, PG8_SP2>(F.lds, g, S, E); }
        { pg8::Gemm g{WIN + (size_t)ZP * DM, XB, 2048, M, DM}; pg8::StaticOrder S; S.init(2048, M, F.G, F.bid);
          pg8::EpiBf16<0> E{VT, M, nullptr, 0, 0, 1.f};
          pg8::gemm_phase<pg8::EpiBf16<0>, pg8::StaticOrder, PG8_ALIGN, PG8_SP2>(F.lds, g, S, E); }
    }
    SEAM(1);
    if (IN(2)) {
        if (F.bid == 0) for (int i = F.tid; i < 1200; i += NTHR) CNT[i] = 0u;
        for (int it = F.bid; it < 32 * 32; it += F.G) kmean_item(F, it, Zb, KMH, KML);
        for (int it = F.bid; it < 32 * 8; it += F.G) hgrn_item<false>(F, it, Zb, VT, args.in[6], ST, DC, args.in[5], OAB);
    }
    SEAM(2);
    if (IN(3)) {
        hgrn_scan(F, ST, DC);
        for (int u = F.bid; u < 32 * 31; u += F.G) gate_unit(F, u & 31, 1 + (u >> 5), Zb, KMH, KML, CNT, LIST);
    }
    SEAM(3);
    if (IN(4)) {
        for (int it = F.bid; it < 32 * 8; it += F.G) hgrn_item<true>(F, it, Zb, VT, args.in[6], ST, DC, args.in[5], OAB);
    }
    if (IN(5)) {
        attn_queue(F, Zb, VT, CNT, CNT + 1024, LIST, (bf16*)args.out, PML);
#ifdef DIAG_CMP
        { const int vcu = (F.bid & 7) * 32 + (F.bid >> 3), bh = vcu >> 3, s = vcu & 7;
          attn_unit(F, bh, s, Zb, VT, KMH, KML, OAB); attn_unit(F, bh, 15 - s, Zb, VT, KMH, KML, OAB);
          attn_unit(F, bh, 16 + s, Zb, VT, KMH, KML, OAB); attn_unit(F, bh, 31 - s, Zb, VT, KMH, KML, OAB); }
#endif
    }
    SEAM(5);
    if (IN(6)) { attn_combine(F, (const bf16*)args.out, PML, OAB); }
    SEAM(6);
    if (IN(7)) {
        pg8::Gemm g{OAB, WP, M, DM, DM}; pg8::StaticOrder S; S.init(M, DM, F.G, F.bid);
        pg8::EpiProj E{Zb, ZP, ZC_GA, ZC_GB, MERGED, DM};
        pg8::gemm_phase<pg8::EpiProj, pg8::StaticOrder, PG8_ALIGN, PG8_SP2>(F.lds, g, S, E);
    }
    SEAM(7);
    if (IN(8)) {
        pg8::Gemm g{MERGED, WO, M, DM, DM}; pg8::StaticOrder S; S.init(M, DM, F.G, F.bid);
        pg8::EpiBf16<0> E{MIX, DM, nullptr, 0, 0, 1.f};
        pg8::gemm_phase<pg8::EpiBf16<0>, pg8::StaticOrder, PG8_ALIGN, PG8_SP2>(F.lds, g, S, E);
    }
    SEAM(8);
    if (IN(9)) {
        for (int mm = F.bid * NWAVES + F.wave; mm < M; mm += F.G * NWAVES) ln1_row(F.lane, args.in[0] + (size_t)mm * DM, MIX + (size_t)mm * DM, args.in[7], args.in[8], H1N + (size_t)mm * DM);
    }
    SEAM(9);
    if (IN(10)) {
        pg8::Gemm g{H1N, WGU, M, 2 * FFH, DM}; pg8::StaticOrder S; S.init(M, 2 * FFH, F.G, F.bid);
        pg8::EpiSwiGLU E{ACT, FFH};
        pg8::gemm_phase<pg8::EpiSwiGLU, pg8::StaticOrder, PG8_ALIGN, PG8_SP2>(F.lds, g, S, E);
    }
    SEAM(10);
    if (IN(11)) {
        pg8::Gemm g{ACT, WD, M, DM, FFH}; pg8::StaticOrder S; S.init(M, DM, F.G, F.bid);
        pg8::EpiPre2 E{H1N, PRE2, DM, ALPHA};
        pg8::gemm_phase<pg8::EpiPre2, pg8::StaticOrder, PG8_ALIGN, PG8_SP2>(F.lds, g, S, E);
    }
    SEAM(11);
    if (IN(12)) {
        for (int mm = F.bid * NWAVES + F.wave; mm < M; mm += F.G * NWAVES) ln2_row(F.lane, PRE2 + (size_t)mm * DM, args.out + (size_t)mm * DM, args.in[12], args.in[13]);
    }
#undef IN
#undef SEAM
}

extern "C" void kernel_launch(void* const* d_in, const int* in_sizes, int n_in, void* d_out, int out_size, void* d_ws, size_t ws_size, hipStream_t stream) {
    static int grid = 0;
    if (grid == 0) {
        if (n_in != 14 || in_sizes[0] != M * DM || out_size != M * DM || ws_size < WS_END) { fprintf(stderr, "kernel_launch: unexpected shapes (n_in %d, in0 %d, out %d, ws %zu)\n", n_in, n_in > 0 ? in_sizes[0] : -1, out_size, ws_size); grid = -1; return; }
        int dev = 0, cus = 0, per_cu = 0;
        if (hipGetDevice(&dev) != hipSuccess || hipDeviceGetAttribute(&cus, hipDeviceAttributeMultiprocessorCount, dev) != hipSuccess) { grid = -1; return; }
        if (hipFuncSetAttribute((const void*)fwd_kernel, hipFuncAttributeMaxDynamicSharedMemorySize, LDS_BYTES) != hipSuccess) { fprintf(stderr, "kernel_launch: hipFuncSetAttribute failed\n"); grid = -1; return; }
        if (hipOccupancyMaxActiveBlocksPerMultiprocessor(&per_cu, (const void*)fwd_kernel, NTHR, LDS_BYTES) != hipSuccess || per_cu < 1) per_cu = 1;
        (void)hipGetLastError();
        grid = cus * per_cu;
    }
    if (grid < 0) return;
    if (hipMemsetAsync((char*)d_ws + WS_BAR, 0, 16384, stream) != hipSuccess) { fprintf(stderr, "kernel_launch: memset of the barrier words failed\n"); return; }
    Args a{};
    for (int i = 0; i < 14; ++i) a.in[i] = (const float*)d_in[i];
    a.out = (float*)d_out; a.ws = (unsigned char*)d_ws;
#if MK_N_LAUNCHES == 1
    a.ph_lo = 0; a.ph_hi = NPHASE;
    void* kargs[] = {&a};
    hipError_t e = hipLaunchCooperativeKernel((const void*)fwd_kernel, dim3(grid), dim3(NTHR), kargs, LDS_BYTES, stream);
    if (e != hipSuccess) fprintf(stderr, "cooperative launch failed: %s (grid %d)\n", hipGetErrorString(e), grid);
#else
    for (int p = 0; p < NPHASE; ++p) { a.ph_lo = p; a.ph_hi = p + 1; hipLaunchKernelGGL(fwd_kernel, dim3(grid), dim3(NTHR), LDS_BYTES, stream, a); }
#endif
}
```
